# Optimizing an MI355X kernel written in HIP

```python
import math
import jax, jax.numpy as jnp
from jax import lax
import numpy as np

D_MODEL = 1024
BATCH = 8
SEQ = 2048
DEPTH = 2

ATTN_HEADS = 8
ATTN_HEAD_DIM = 64
ATTN_WIDTH = ATTN_HEADS * ATTN_HEAD_DIM
DILATED_PATTERNS = ((128, 1), (512, 4), (2048, 16))
BLOCK = 128
NUM_BUCKETS = 32
MAX_DISTANCE = 2048
RET_HEADS = 4
RET_KEY_DIM = 64
RET_VALUE_DIM = 128
RET_WIDTH = RET_HEADS * RET_VALUE_DIM
RET_CHUNK = 128
ROPE_BASE = 10000.0
MIX_WIDTH = ATTN_WIDTH + RET_WIDTH
IN_SPLITS = (ATTN_WIDTH, ATTN_WIDTH, ATTN_WIDTH, RET_HEADS * RET_KEY_DIM,
             RET_HEADS * RET_KEY_DIM, RET_WIDTH, RET_WIDTH)
IN_WIDTH = sum(IN_SPLITS)
D_FF = 2816
N_EXPERTS = 8
TOP_K = 2
D_FF_EXPERT = 3584
N_DENSE = (DEPTH + 1) // 2
N_MOE = DEPTH // 2
EPS = 1e-6
NEG_INF = -1e30

kernel_name = 'hybrid_dilated_retention_moe_block'


def rms_norm(x, gain):
    xf = x.astype(jnp.float32)
    y = xf * lax.rsqrt(jnp.mean(xf * xf, axis=-1, keepdims=True) + EPS)
    return y * gain.astype(jnp.float32)


def t5_bucket(distance):
    max_exact = NUM_BUCKETS // 2
    n = jnp.maximum(distance, 0)
    nf = jnp.maximum(n.astype(jnp.float32), float(max_exact))
    large = max_exact + (jnp.log(nf / max_exact) / math.log(MAX_DISTANCE / max_exact)
                         * (NUM_BUCKETS - max_exact)).astype(jnp.int32)
    large = jnp.minimum(large, NUM_BUCKETS - 1)
    return jnp.where(n < max_exact, n, large)


def dilated_branch(q, k, v, bias_table, window, dilation):
    B, S, H, E = q.shape
    L = S // dilation
    w_sub = window // dilation
    nb = -(-L // BLOCK)
    pad_r = nb * BLOCK - L

    def to_sub(t):
        return t.reshape(B, L, dilation, H, E).transpose(0, 2, 3, 1, 4)

    qb = jnp.pad(to_sub(q), ((0, 0), (0, 0), (0, 0), (0, pad_r), (0, 0)))
    qb = qb.reshape(B, dilation, H, nb, BLOCK, E)

    def kv_windows(t):
        t = jnp.pad(to_sub(t), ((0, 0), (0, 0), (0, 0), (BLOCK, pad_r), (0, 0)))
        t = t.reshape(B, dilation, H, nb + 1, BLOCK, E)
        return jnp.concatenate([t[:, :, :, :-1], t[:, :, :, 1:]], axis=4)

    kw = kv_windows(k)
    vw = kv_windows(v)
    i = jnp.arange(BLOCK)[:, None]
    j = jnp.arange(2 * BLOCK)[None, :]
    rel = i - j + BLOCK
    kpos = jnp.arange(nb)[:, None, None] * BLOCK + j - BLOCK
    allowed = (rel >= 0) & (rel <= w_sub) & (kpos >= 0)
    bias = jnp.transpose(bias_table[t5_bucket(rel * dilation)], (2, 0, 1)).astype(jnp.float32)

    s = jnp.einsum('bdhnqe,bdhnke->bdhnqk', qb, kw) * (E ** -0.5) + bias[None, None, :, None]
    s = jnp.where(allowed[None, None, None], s, NEG_INF)
    m = jnp.max(s, axis=-1, keepdims=True)
    p = jnp.exp(s - m)
    den = jnp.sum(p, axis=-1, keepdims=True)
    o = jnp.einsum('bdhnqk,bdhnke->bdhnqe', p, vw) / den
    lse = (m + jnp.log(den))[..., 0]

    def from_sub(t):
        rest = t.shape[5:]
        t = t.reshape((B, dilation, H, nb * BLOCK) + rest)[:, :, :, :L]
        t = jnp.moveaxis(t, 3, 1)
        return t.reshape((B, S, H) + rest)

    return from_sub(o), from_sub(lse)


def dilated_attention(q, k, v, bias_table):
    outs, lses = [], []
    for window, dilation in DILATED_PATTERNS:
        o, l = dilated_branch(q, k, v, bias_table, window, dilation)
        outs.append(o)
        lses.append(l)
    outs = jnp.stack(outs, axis=0)
    weights = jax.nn.softmax(jnp.stack(lses, axis=0), axis=0)
    return jnp.sum(weights[..., None] * outs, axis=0)


def rotary(t, pos):
    half = t.shape[-1] // 2
    inv = ROPE_BASE ** (-jnp.arange(half, dtype=jnp.float32) / half)
    ang = pos[:, None] * inv[None, :]
    cos = jnp.cos(ang)[None, :, None, :]
    sin = jnp.sin(ang)[None, :, None, :]
    t1, t2 = t[..., :half], t[..., half:]
    return jnp.concatenate([t1 * cos - t2 * sin, t1 * sin + t2 * cos], axis=-1)


def retention_chunkwise(q, k, v):
    B, S, H, Dk = q.shape
    Dv = v.shape[-1]
    nc = S // RET_CHUNK
    log_g = jnp.log(1.0 - 2.0 ** (-5.0 - jnp.arange(H, dtype=jnp.float32)))
    idx = jnp.arange(RET_CHUNK, dtype=jnp.float32)
    diff = idx[:, None] - idx[None, :]
    decay_mask = jnp.where(diff >= 0, jnp.exp(jnp.maximum(diff, 0.0)[None] * log_g[:, None, None]), 0.0)
    q_decay = jnp.exp((idx + 1.0)[None, :] * log_g[:, None])[..., None]
    k_decay = jnp.exp((RET_CHUNK - 1.0 - idx)[None, :] * log_g[:, None])[..., None]
    chunk_decay = jnp.exp(RET_CHUNK * log_g)[:, None, None]

    def chunks(t):
        return t.reshape(B, nc, RET_CHUNK, H, t.shape[-1]).transpose(1, 0, 3, 2, 4)

    def step(state, inp):
        qi, ki, vi = inp
        inner = jnp.einsum('bhqd,bhkd->bhqk', qi, ki) * decay_mask
        inner = jnp.einsum('bhqk,bhkv->bhqv', inner, vi)
        cross = jnp.einsum('bhqd,bhdv->bhqv', qi * q_decay, state)
        new_state = state * chunk_decay + jnp.einsum('bhkd,bhkv->bhdv', ki * k_decay, vi)
        return new_state, inner + cross

    state0 = jnp.zeros((B, H, Dk, Dv), jnp.float32)
    _, ys = lax.scan(step, state0, (chunks(q), chunks(k), chunks(v)))
    return ys.transpose(1, 0, 3, 2, 4).reshape(B, S, H, Dv)


def token_mixer(h, w_in, q_gain, k_gain, ret_gain, w_out, bias_table):
    B, S, _ = h.shape
    proj = jnp.einsum('bsd,de->bse', h, w_in).astype(jnp.float32)
    q, k, v, rq, rk, rv, rg = jnp.split(proj, np.cumsum(IN_SPLITS)[:-1].tolist(), axis=-1)
    q = rms_norm(q.reshape(B, S, ATTN_HEADS, ATTN_HEAD_DIM), q_gain)
    k = rms_norm(k.reshape(B, S, ATTN_HEADS, ATTN_HEAD_DIM), k_gain)
    v = v.reshape(B, S, ATTN_HEADS, ATTN_HEAD_DIM)
    attn = dilated_attention(q, k, v, bias_table).reshape(B, S, ATTN_WIDTH)
    pos = jnp.arange(S, dtype=jnp.float32)
    rq = rotary(rq.reshape(B, S, RET_HEADS, RET_KEY_DIM), pos) * (RET_KEY_DIM ** -0.5)
    rk = rotary(rk.reshape(B, S, RET_HEADS, RET_KEY_DIM), pos)
    rv = rv.reshape(B, S, RET_HEADS, RET_VALUE_DIM)
    ret = retention_chunkwise(rq, rk, rv)
    mu = jnp.mean(ret, axis=-1, keepdims=True)
    var = jnp.mean(jnp.square(ret - mu), axis=-1, keepdims=True)
    ret = ((ret - mu) * lax.rsqrt(var + EPS)).reshape(B, S, RET_WIDTH) * ret_gain.astype(jnp.float32)
    ret = jax.nn.silu(rg) * ret
    mixed = jnp.concatenate([attn, ret], axis=-1).astype(h.dtype)
    return jnp.einsum('bsm,md->bsd', mixed, w_out)


def swiglu(h, w1, w3, w2):
    a = jnp.einsum('bsd,df->bsf', h, w1)
    b = jnp.einsum('bsd,df->bsf', h, w3)
    return jnp.einsum('bsf,fd->bsd', jax.nn.silu(a) * b, w2)


def moe_swiglu(h, router, w1, w3, w2):
    logits = jnp.einsum('bsd,de->bse', h, router).astype(jnp.float32)
    top_vals, top_idx = lax.top_k(logits, TOP_K)
    top_w = jax.nn.softmax(top_vals, axis=-1)
    gates = jnp.sum(jax.nn.one_hot(top_idx, N_EXPERTS, dtype=jnp.float32) * top_w[..., None], axis=-2)
    out = jnp.zeros(h.shape, jnp.float32)
    for e in range(N_EXPERTS):
        out = out + gates[..., e:e + 1] * swiglu(h, w1[e], w3[e], w2[e]).astype(jnp.float32)
    return out


def setup_inputs(seed: int = 0) -> dict:
    key = jax.random.key(seed)
    ks = jax.random.split(key, 20)
    f32 = jnp.float32
    nrm = lambda k, shape, scale: jax.random.normal(k, shape, f32) * scale
    return {
        'x': nrm(ks[0], (BATCH, SEQ, D_MODEL), 1.0),
        'c': nrm(ks[1], (BATCH, D_MODEL), 1.0),
        'rel_bias_table': nrm(ks[2], (NUM_BUCKETS, ATTN_HEADS), 0.3),
        'norm_mix': 1.0 + nrm(ks[3], (DEPTH, D_MODEL), 0.02),
        'norm_ffn': 1.0 + nrm(ks[4], (DEPTH, D_MODEL), 0.02),
        'w_mod': nrm(ks[5], (DEPTH, D_MODEL, 6 * D_MODEL), 0.3 * D_MODEL ** -0.5),
        'b_mod': nrm(ks[6], (DEPTH, 6 * D_MODEL), 0.02),
        'w_in': nrm(ks[7], (DEPTH, D_MODEL, IN_WIDTH), D_MODEL ** -0.5),
        'q_gain': 1.0 + nrm(ks[8], (DEPTH, ATTN_HEAD_DIM), 0.02),
        'k_gain': 1.0 + nrm(ks[9], (DEPTH, ATTN_HEAD_DIM), 0.02),
        'ret_gain': 1.0 + nrm(ks[10], (DEPTH, RET_WIDTH), 0.02),
        'w_out': nrm(ks[11], (DEPTH, MIX_WIDTH, D_MODEL), MIX_WIDTH ** -0.5),
        'ffn_w1': nrm(ks[12], (N_DENSE, D_MODEL, D_FF), D_MODEL ** -0.5),
        'ffn_w3': nrm(ks[13], (N_DENSE, D_MODEL, D_FF), D_MODEL ** -0.5),
        'ffn_w2': nrm(ks[14], (N_DENSE, D_FF, D_MODEL), D_FF ** -0.5),
        'moe_router': nrm(ks[15], (N_MOE, D_MODEL, N_EXPERTS), D_MODEL ** -0.5),
        'moe_w1': nrm(ks[16], (N_MOE, N_EXPERTS, D_MODEL, D_FF_EXPERT), D_MODEL ** -0.5),
        'moe_w3': nrm(ks[17], (N_MOE, N_EXPERTS, D_MODEL, D_FF_EXPERT), D_MODEL ** -0.5),
        'moe_w2': nrm(ks[18], (N_MOE, N_EXPERTS, D_FF_EXPERT, D_MODEL), D_FF_EXPERT ** -0.5),
    }


def reference(x, c, rel_bias_table, norm_mix, norm_ffn, w_mod, b_mod, w_in, q_gain, k_gain,
              ret_gain, w_out, ffn_w1, ffn_w3, ffn_w2, moe_router, moe_w1, moe_w3, moe_w2):
    dt = x.dtype
    c_act = jax.nn.silu(c.astype(jnp.float32))
    for layer in range(DEPTH):
        mod = jnp.einsum('bd,de->be', c_act, w_mod[layer].astype(jnp.float32)) + b_mod[layer].astype(jnp.float32)
        shift_m, scale_m, gate_m, shift_f, scale_f, gate_f = jnp.split(mod[:, None, :], 6, axis=-1)
        h = (rms_norm(x, norm_mix[layer]) * (1.0 + scale_m) + shift_m).astype(dt)
        mix = token_mixer(h, w_in[layer], q_gain[layer], k_gain[layer], ret_gain[layer],
                          w_out[layer], rel_bias_table)
        x = x + (gate_m * mix.astype(jnp.float32)).astype(dt)
        h = (rms_norm(x, norm_ffn[layer]) * (1.0 + scale_f) + shift_f).astype(dt)
        if layer % 2 == 0:
            i = layer // 2
            f = swiglu(h, ffn_w1[i], ffn_w3[i], ffn_w2[i])
        else:
            i = layer // 2
            f = moe_swiglu(h, moe_router[i], moe_w1[i], moe_w3[i], moe_w2[i])
        x = x + (gate_f * f.astype(jnp.float32)).astype(dt)
    return x
```

```cpp
#include <hip/hip_runtime.h>
#include <cstdio>
#include <cstdint>
#include <cmath>
namespace pg8 {
#define PG8_LAS __attribute__((address_space(3)))
typedef unsigned short bf16_t;
typedef short bf16x8 __attribute__((ext_vector_type(8)));
typedef float f32x4 __attribute__((ext_vector_type(4)));
typedef unsigned u32x4 __attribute__((ext_vector_type(4)));
constexpr int BM = 256, BK = 64, HALF = 128, HTB = HALF * BK * 2  , STAGE_BYTES = 8 * HTB, NXCD = 8, WGM = 8;

__host__ __device__ __forceinline__ int lds_byte(int r, int c) { const int st = (r >> 4) * 2 + (c >> 5), rr = r & 15, cc = c & 31, ob = rr * 64 + cc * 2; return st * 1024 + (ob ^ (((ob >> 9) & 1) << 5)); }
__host__ __device__ __forceinline__ void stage_rc(int b, int& R, int& C) { const int st = b / 1024, sb = b % 1024, swz = sb ^ (((sb >> 9) & 1) << 5); R = (st >> 1) * 16 + swz / 64; C = (st & 1) * 32 + (swz % 64) / 2; }
__host__ __device__ __forceinline__ int perm32(int rho) { const int n = rho >> 4, i = rho & 15; return 8 * (i >> 2) + 4 * n + (i & 3); }

struct Unit { int pm, pn; };
struct Gemm { const bf16_t* A; const bf16_t* Bt; int M, N, K; const int* rowidx; };

struct StaticOrder {
    int nM, nN, nwg, G, c;
    __host__ __device__ void init(int M, int N, int G_, int c_) { nM = M / BM; nN = N / BM; nwg = nM * nN; G = G_; c = c_; }
    __host__ __device__ bool next(int i, Unit& u) const {
        const long L = (long)i * G + c; if (L >= nwg) return false;
        int wgid = (int)L; { const int q = nwg / NXCD, r = nwg % NXCD, xcd = wgid % NXCD, off = wgid / NXCD; wgid = (xcd < r ? xcd * (q + 1) : r * (q + 1) + (xcd - r) * q) + off; }
        const int nig = WGM * nN, gid = wgid / nig, fm = gid * WGM, gsz = (nM - fm) < WGM ? (nM - fm) : WGM;
        u.pm = fm + ((wgid % nig) % gsz); u.pn = (wgid % nig) / gsz; return true;
    }
    __device__ __forceinline__ void a_ready(const Unit&) const {}
    __device__ __forceinline__ void done(const Unit&) const {}
};

__device__ __forceinline__ unsigned cvt_pk_bf16(float lo, float hi) { unsigned r; asm volatile("v_cvt_pk_bf16_f32 %0, %1, %2" : "=v"(r) : "v"(lo), "v"(hi)); return r; }
typedef float f32x2 __attribute__((ext_vector_type(2)));
template <class Epi, class Sched, bool GATHER>
__device__ __forceinline__ void gemm_phase(PG8_LAS unsigned char* lds, const Gemm g, const Sched& S, const Epi& E) {
    int tid_ = threadIdx.x; asm volatile("" : "+v"(tid_));
    const int tid = tid_, wid = __builtin_amdgcn_readfirstlane(tid >> 6), lane = tid & 63, wr = wid >> 2, wc = wid & 3, fr = lane & 15, fq = lane >> 4;
    const int K = g.K, nt = K / BK;
    const size_t kstep = (size_t)(BK * 2);
    const size_t hstep = (size_t)HALF * K * 2;
    const size_t tstep = 2 * hstep;
    int RA[2], CA2[2]; unsigned voffB[2];
#pragma unroll
    for (int i = 0; i < 2; ++i) { int R, C; stage_rc(tid * 16 + i * 8192, R, C); const int Rb = Epi::PERM ? ((R & ~31) + perm32(R & 31)) : R;
        RA[i] = R; CA2[i] = C * 2; voffB[i] = (unsigned)(Rb * K + C) * 2u; }
    unsigned cv00, cv01, cv10, cv11, nv00, nv01, nv10, nv11;
    const unsigned ldsw = (unsigned)wid * 1024u;
    const int aoff = lds_byte(wr * 64 + fr, fq * 8), boff = lds_byte(wc * 32 + fr, fq * 8);
#define PG8_SA(b, h) (((b) * 2 + (h)) * HTB)
#define PG8_SB(b, h) ((4 + (b) * 2 + (h)) * HTB)
#define PG8_STAGE(bufoff, gbase, voff) do { _Pragma("unroll") for (int _i = 0; _i < 2; ++_i) \
        __builtin_amdgcn_global_load_lds((const unsigned*)((const char*)(gbase) + (voff)[_i]), (PG8_LAS unsigned*)(lds + (bufoff) + ldsw + _i * 8192), 16, 0, 0); } while (0)
#define PG8_STAGEA(bufoff, gbase, v0, v1) do { \
        __builtin_amdgcn_global_load_lds((const unsigned*)((const char*)(gbase) + (v0)), (PG8_LAS unsigned*)(lds + (bufoff) + ldsw), 16, 0, 0); \
        __builtin_amdgcn_global_load_lds((const unsigned*)((const char*)(gbase) + (v1)), (PG8_LAS unsigned*)(lds + (bufoff) + ldsw + 8192), 16, 0, 0); } while (0)
#define PG8_LDA(dst, b, h) do { _Pragma("unroll") for (int m = 0; m < 4; ++m) _Pragma("unroll") for (int k = 0; k < 2; ++k) dst[m][k] = *(const PG8_LAS bf16x8*)(lds + PG8_SA(b, h) + aoff + m * 2048 + k * 1024); } while (0)
#define PG8_LDB(dst, b, h) do { _Pragma("unroll") for (int n = 0; n < 2; ++n) _Pragma("unroll") for (int k = 0; k < 2; ++k) dst[n][k] = *(const PG8_LAS bf16x8*)(lds + PG8_SB(b, h) + boff + n * 2048 + k * 1024); } while (0)
#define PG8_MMA(ai, bj, At, Bt) do { __builtin_amdgcn_s_setprio(1); _Pragma("unroll") for (int m = 0; m < 4; ++m) _Pragma("unroll") for (int n = 0; n < 2; ++n) _Pragma("unroll") for (int k = 0; k < 2; ++k) \
        acc[ai][bj][m][n] = __builtin_amdgcn_mfma_f32_16x16x32_bf16(Bt[n][k], At[m][k], acc[ai][bj][m][n], 0, 0, 0); __builtin_amdgcn_s_setprio(0); } while (0)
#define PG8_WAIT_V(n) asm volatile("s_waitcnt vmcnt(" #n ")" ::: "memory")
#define PG8_WAIT_L(n) asm volatile("s_waitcnt lgkmcnt(" #n ")" ::: "memory")
#define PG8_BAR __builtin_amdgcn_s_barrier()
#define PG8_SCHED __builtin_amdgcn_sched_barrier(0)
#define PG8_AOFFS(u, o00, o01, o10, o11) do { \
        if constexpr (GATHER) { const int* ri_ = g.rowidx + (size_t)(u).pm * BM; \
            const int r00 = ri_[RA[0]], r01 = ri_[RA[1]], r10 = ri_[HALF + RA[0]], r11 = ri_[HALF + RA[1]]; \
            o00 = (unsigned)r00 * (unsigned)(K * 2) + (unsigned)CA2[0]; o01 = (unsigned)r01 * (unsigned)(K * 2) + (unsigned)CA2[1]; \
            o10 = (unsigned)r10 * (unsigned)(K * 2) + (unsigned)CA2[0]; o11 = (unsigned)r11 * (unsigned)(K * 2) + (unsigned)CA2[1]; } \
        else { o00 = (unsigned)(RA[0] * K * 2 + CA2[0]); o01 = (unsigned)(RA[1] * K * 2 + CA2[1]); o10 = o00 + (unsigned)hstep; o11 = o01 + (unsigned)hstep; } } while (0)
    Unit cur, nxt; int ui = 0;
    if (!S.next(0, cur)) return;
    f32x4 acc[2][2][4][2];
#pragma unroll
    for (int a = 0; a < 2; ++a)
#pragma unroll
        for (int b = 0; b < 2; ++b)
#pragma unroll
            for (int m = 0; m < 4; ++m)
#pragma unroll
                for (int n = 0; n < 2; ++n) acc[a][b][m][n] = (f32x4){0.f, 0.f, 0.f, 0.f};
    bf16x8 At[4][2], B0[2][2], B1[2][2];
    const char* cA = GATHER ? (const char*)g.A : (const char*)g.A + (size_t)cur.pm * tstep; const char* cB = (const char*)g.Bt + (size_t)cur.pn * tstep;
    PG8_AOFFS(cur, cv00, cv01, cv10, cv11);
    if constexpr (GATHER) { asm volatile("s_waitcnt vmcnt(0)" ::: "memory"); }
    S.a_ready(cur);
    PG8_STAGE(PG8_SB(0, 0), cB, voffB); PG8_STAGE(PG8_SB(0, 1), cB + hstep, voffB); PG8_STAGEA(PG8_SA(0, 0), cA, cv00, cv01); PG8_STAGEA(PG8_SA(0, 1), cA, cv10, cv11);
    if (wr == 1) PG8_BAR;
    PG8_WAIT_V(2); PG8_BAR;
    PG8_STAGE(PG8_SB(1, 0), cB + kstep, voffB); PG8_STAGEA(PG8_SA(1, 0), cA + kstep, cv00, cv01); PG8_STAGE(PG8_SB(1, 1), cB + hstep + kstep, voffB);
    PG8_WAIT_V(6); PG8_BAR;
    for (;;) {
        const bool has_next = S.next(ui + 1, nxt);
        const char* nA = (has_next && !GATHER) ? (const char*)g.A + (size_t)nxt.pm * tstep : cA; const char* nB = has_next ? (const char*)g.Bt + (size_t)nxt.pn * tstep : cB;
        if constexpr (GATHER) {
            if (has_next) { PG8_AOFFS(nxt, nv00, nv01, nv10, nv11); } else { nv00 = cv00; nv01 = cv01; nv10 = cv10; nv11 = cv11; }
        } else { nv00 = cv00; nv01 = cv01; nv10 = cv10; nv11 = cv11; }
        for (int t = 0; t < nt; t += 2) {
            const bool last = (t == nt - 2);
            const char* a1 = cA + (size_t)(t + 1) * kstep;
            const char* a2 = last ? nA : cA + (size_t)(t + 2) * kstep; const char* b2 = last ? nB : cB + (size_t)(t + 2) * kstep;
            const char* a3 = a2 + kstep; const char* b3 = b2 + kstep;
            unsigned x00 = cv00, x01 = cv01, x10 = cv10, x11 = cv11;
            if constexpr (GATHER) { if (last) { x00 = nv00; x01 = nv01; x10 = nv10; x11 = nv11; } }
            if (last && has_next) S.a_ready(nxt);
            PG8_LDB(B0, 0, 0); PG8_LDB(B1, 0, 1); PG8_SCHED; PG8_LDA(At, 0, 0); PG8_STAGEA(PG8_SA(1, 1), a1, cv10, cv11);
            PG8_WAIT_V(8); PG8_WAIT_L(0); PG8_BAR; PG8_MMA(0, 0, At, B0); PG8_MMA(0, 1, At, B1); PG8_BAR; PG8_SCHED;
            PG8_LDA(At, 0, 1); PG8_STAGE(PG8_SB(0, 0), b2, voffB); PG8_STAGE(PG8_SB(0, 1), b2 + hstep, voffB); PG8_STAGEA(PG8_SA(0, 0), a2, x00, x01);
            PG8_WAIT_V(8); PG8_WAIT_L(0); PG8_BAR; PG8_MMA(1, 0, At, B0); PG8_MMA(1, 1, At, B1); PG8_BAR; PG8_SCHED;
            PG8_LDB(B0, 1, 0); PG8_LDB(B1, 1, 1); PG8_SCHED; PG8_LDA(At, 1, 0); PG8_STAGEA(PG8_SA(0, 1), a2, x10, x11);
            PG8_WAIT_V(8); PG8_WAIT_L(0); PG8_BAR; PG8_MMA(0, 0, At, B0); PG8_MMA(0, 1, At, B1); PG8_BAR; PG8_SCHED;
            PG8_LDA(At, 1, 1); PG8_STAGE(PG8_SB(1, 0), b3, voffB); PG8_STAGE(PG8_SB(1, 1), b3 + hstep, voffB); PG8_STAGEA(PG8_SA(1, 0), a3, x00, x01);
            PG8_WAIT_V(8); PG8_WAIT_L(0); PG8_BAR; PG8_MMA(1, 0, At, B0); PG8_MMA(1, 1, At, B1); PG8_BAR; PG8_SCHED;
        }
        if (wr == 0) PG8_BAR;
        E(acc, cur, wr, wc, fr, fq); S.done(cur);
        if (!has_next) break;
#pragma unroll
        for (int a = 0; a < 2; ++a)
#pragma unroll
            for (int b = 0; b < 2; ++b)
#pragma unroll
                for (int m = 0; m < 4; ++m)
#pragma unroll
                    for (int n = 0; n < 2; ++n) acc[a][b][m][n] = (f32x4){0.f, 0.f, 0.f, 0.f};
        cur = nxt; cA = nA; cB = nB; ++ui; cv00 = nv00; cv01 = nv01; cv10 = nv10; cv11 = nv11;
        if (wr == 1) PG8_BAR;
    }
    PG8_WAIT_V(0);
    PG8_BAR;
#undef PG8_SA
#undef PG8_SB
#undef PG8_STAGE
#undef PG8_STAGEA
#undef PG8_LDA
#undef PG8_LDB
#undef PG8_MMA
#undef PG8_WAIT_V
#undef PG8_WAIT_L
#undef PG8_BAR
#undef PG8_SCHED
#undef PG8_AOFFS
}
}
#define GAS __attribute__((address_space(1)))
#define LAS __attribute__((address_space(3)))
typedef unsigned short bf16;
typedef unsigned v4u __attribute__((ext_vector_type(4)));
typedef float f32x4 __attribute__((ext_vector_type(4)));
typedef short bf16x8 __attribute__((ext_vector_type(8)));
typedef GAS unsigned gu32;
typedef GAS unsigned long long gu64;
#define RLX_AGENT __ATOMIC_RELAXED, __HIP_MEMORY_SCOPE_AGENT
#define LDS_WAIT() asm volatile("s_waitcnt lgkmcnt(0)" ::: "memory")
#define VM_WAIT() asm volatile("s_waitcnt vmcnt(0)" ::: "memory")
__device__ __forceinline__ unsigned long long rt() { return __builtin_amdgcn_s_memrealtime(); }
__device__ __forceinline__ unsigned f2bf(float f) { unsigned u = __builtin_bit_cast(unsigned, f); return (u + 0x7fffu + ((u >> 16) & 1u)) >> 16; }
__device__ __forceinline__ unsigned pk2(float lo, float hi) { return f2bf(lo) | (f2bf(hi) << 16); }

#define XB_TMO      128
#define XB_XCNT(j)  (256  + 64 * (j))
#define XB_XSUB(j)  (1280 + 64 * (j))
#define XB_XGEN(j)  (2304 + 64 * (j))
#define XB_TOP      3328
#define XB_TOPGEN   3392
#define XCD_BAR_WORDS 3456
#define XB_SPIN_CAP (1u << 18)

__device__ __forceinline__ unsigned xb_ld(unsigned* p)              { return __hip_atomic_load(p, __ATOMIC_RELAXED, __HIP_MEMORY_SCOPE_AGENT); }
__device__ __forceinline__ unsigned xb_add(unsigned* p, unsigned v) { return __hip_atomic_fetch_add(p, v, __ATOMIC_RELAXED, __HIP_MEMORY_SCOPE_AGENT); }
__device__ __forceinline__ unsigned xb_xcc_id() { return (unsigned)__builtin_amdgcn_s_getreg((3 << 11) | 20) & 0xFu; }
#define XB_SPIN(cond, bar) do { unsigned _sp = 0; while (cond) { __builtin_amdgcn_s_sleep(1); \
    if ((++_sp & 255u) == 0u) { if (xb_ld(&(bar)[XB_TMO])) break; if (_sp > XB_SPIN_CAP) { atomicAdd(&(bar)[XB_TMO], 1u); break; } } } } while (0)

struct XcdBarrier {
    unsigned* bar; unsigned x;
    volatile LAS unsigned* st;
};

__device__ __forceinline__ XcdBarrier xcd_barrier_post(unsigned* bar, volatile LAS unsigned* st) {
    XcdBarrier b; b.bar = bar; b.x = xb_xcc_id(); b.st = st;
    if (threadIdx.x == 0) (void)xb_add(&bar[XB_XCNT(b.x)], 1u);
    return b;
}
__device__ __forceinline__ void xcd_barrier_complete(unsigned* bar, unsigned x, unsigned& nloc, unsigned& nx) {
    const unsigned G = gridDim.x * gridDim.y * gridDim.z;
    unsigned sum, cnt, mine, sp = 0u;
    for (;;) {
        sum = 0u; cnt = 0u; mine = 0u;
#pragma unroll
        for (unsigned j = 0; j < 16; ++j) { const unsigned c = xb_ld(&bar[XB_XCNT(j)]); sum += c; cnt += (c > 0u) ? 1u : 0u; mine = (j == x) ? c : mine; }
        if (sum == G) break;
        __builtin_amdgcn_s_sleep(1);
        if ((++sp & 255u) == 0u) { if (xb_ld(&bar[XB_TMO])) break; if (sp > XB_SPIN_CAP) { atomicAdd(&bar[XB_TMO], 1u); break; } }
    }
    nloc = mine > 0u ? mine : 1u; nx = cnt > 0u ? cnt : 1u;
}

__device__ __forceinline__ void xcd_barrier(const XcdBarrier& b) {
    asm volatile("s_waitcnt vmcnt(0)" ::: "memory");
    __syncthreads();
    if (threadIdx.x == 0) {
        unsigned* bar = b.bar;
        __builtin_amdgcn_s_waitcnt(0);
        unsigned nloc = b.st[0], nx = b.st[1];
        if (nloc == 0u) { xcd_barrier_complete(bar, b.x, nloc, nx); b.st[0] = nloc; b.st[1] = nx; }
        const unsigned old = xb_add(&bar[XB_XSUB(b.x)], 1u);
        const unsigned gen = old / nloc;
        if (old + 1u == (gen + 1u) * nloc) {
            __builtin_amdgcn_fence(__ATOMIC_RELEASE, "agent");
            asm volatile("s_waitcnt vmcnt(0)" ::: "memory");
            const unsigned og = xb_add(&bar[XB_TOP], 1u);
            const unsigned tg = og / nx;
            if (og + 1u == (tg + 1u) * nx) xb_add(&bar[XB_TOPGEN], 1u);
            else XB_SPIN(xb_ld(&bar[XB_TOPGEN]) == tg, bar);
            __builtin_amdgcn_fence(__ATOMIC_ACQUIRE, "agent");
            xb_add(&bar[XB_XGEN(b.x)], 1u);
            asm volatile("s_waitcnt vmcnt(0)" ::: "memory");
        } else {
            XB_SPIN(xb_ld(&bar[XB_XGEN(b.x)]) == gen, bar);
            __builtin_amdgcn_fence(__ATOMIC_ACQUIRE, "agent");
            asm volatile("s_waitcnt vmcnt(0)" ::: "memory");
        }
    }
    __syncthreads();
}

constexpr int NWAVES = 8, NTHR = NWAVES * 64;
constexpr int BATCH = 8, SEQ = 2048, D = 1024, M = BATCH * SEQ;
constexpr int NIN = 3072, AW = 512, NHEAD = 8, HD = 64, RH = 4, RDK = 64, RDV = 128;
constexpr int DFF = 2816, NE = 8, DFE = 3584;
constexpr int MODW = 6 * D;
constexpr int MAXTILES = 136, MAXSLOT = MAXTILES * 256;
constexpr float EPS = 1e-6f;

constexpr size_t MiB = 1u << 20;
constexpr size_t WS_CTL = 0, CTL_ZERO_BYTES = 1 * MiB;
constexpr size_t WS_MOD = 1 * MiB;
constexpr size_t WS_ROPE = WS_MOD + 512 * 1024;
constexpr size_t WS_TOK = 2 * MiB;
constexpr size_t TOK_E = WS_TOK, TOK_W = TOK_E + 131072, TOK_SLOT = TOK_W + 131072, TOK_DST = TOK_SLOT + 131072, SORTED_TOK = TOK_DST + 131072, SLOT_W = SORTED_TOK + MAXSLOT * 4;
static_assert(SLOT_W + MAXSLOT * 4 <= 3 * MiB, "tok tables");
constexpr size_t WS_MOE13 = 3 * MiB;
constexpr size_t WS_MOE2 = 115 * MiB;
constexpr size_t WS_WIN = 171 * MiB;
constexpr size_t WS_WOUT = 183 * MiB;
constexpr size_t WS_F13 = 187 * MiB;
constexpr size_t WS_F2 = 198 * MiB;
constexpr size_t WS_H = 204 * MiB;
constexpr size_t WS_Y = 171 * MiB;
constexpr size_t WS_ARENA = 240 * MiB;
constexpr size_t WS_Q = WS_ARENA, WS_K = WS_ARENA + 16 * MiB, WS_V = WS_ARENA + 32 * MiB, WS_RQ = WS_ARENA + 48 * MiB, WS_RK = WS_ARENA + 56 * MiB,
                 WS_RV = WS_ARENA + 64 * MiB, WS_RG = WS_ARENA + 80 * MiB, WS_ATTO = WS_ARENA + 96 * MiB, WS_LSE = WS_ARENA + 144 * MiB,
                 WS_KVST = WS_ARENA + 146 * MiB, WS_MIXED = WS_ARENA + 162 * MiB;
constexpr size_t WS_HID = WS_ARENA;
constexpr size_t WS_END = 478 * MiB;
static_assert(WS_Y + (size_t)MAXSLOT * D * 2 <= WS_ARENA && WS_HID + (size_t)MAXSLOT * DFE * 2 <= WS_END && WS_MIXED + 32 * MiB <= WS_END, "ws map");
constexpr int CW_TMO = 0, CW_CODE = 1;
constexpr int CW_CNT = 8192;
constexpr int CW_BAR = 16384;
constexpr int MAX_BAR_REGIONS = 24;
static_assert((CW_BAR + MAX_BAR_REGIONS * XCD_BAR_WORDS) * 4 <= (int)CTL_ZERO_BYTES, "CTL words inside the memset region");

constexpr int RING_OFF = 0, RING_BYTES = 131072;
constexpr int LDSCTL_OFF = RING_BYTES, MISC_OFF = LDSCTL_OFF + 320;
constexpr int LDS_BYTES = 147456;
static_assert(MISC_OFF + 128 <= LDS_BYTES, "LDS map");

__device__ const unsigned char T5_BUCKET[3][132] = {
{0,1,2,3,4,5,6,7,8,9,10,11,12,13,14,15,16,16,16,16,16,16,17,17,17,17,17,17,17,17,18,18,18,18,18,18,18,18,18,18,19,19,19,19,19,19,19,19,19,19,19,19,19,19,20,20,20,20,20,20,20,20,20,20,20,20,20,20,20,20,20,20,20,21,21,21,21,21,21,21,21,21,21,21,21,21,21,21,21,21,21,21,21,21,21,21,21,21,21,22,22,22,22,22,22,22,22,22,22,22,22,22,22,22,22,22,22,22,22,22,22,22,22,22,22,22,22,22,22,0,0,0},
{0,4,8,12,16,16,17,17,18,18,19,19,19,19,20,20,20,20,20,21,21,21,21,21,21,22,22,22,22,22,22,22,22,22,23,23,23,23,23,23,23,23,23,23,23,23,24,24,24,24,24,24,24,24,24,24,24,24,24,24,24,24,25,25,25,25,25,25,25,25,25,25,25,25,25,25,25,25,25,25,25,25,25,26,26,26,26,26,26,26,26,26,26,26,26,26,26,26,26,26,26,26,26,26,26,26,26,26,26,26,26,26,26,27,27,27,27,27,27,27,27,27,27,27,27,27,27,27,27,0,0,0},
{0,16,18,19,20,21,21,22,22,23,23,23,24,24,24,24,25,25,25,25,25,26,26,26,26,26,26,26,26,27,27,27,27,27,27,27,27,27,27,28,28,28,28,28,28,28,28,28,28,28,28,28,29,29,29,29,29,29,29,29,29,29,29,29,29,29,29,29,29,29,30,30,30,30,30,30,30,30,30,30,30,30,30,30,30,30,30,30,30,30,30,30,30,30,30,31,31,31,31,31,31,31,31,31,31,31,31,31,31,31,31,31,31,31,31,31,31,31,31,31,31,31,31,31,31,31,31,31,31,0,0,0}};

using pg8::Unit; using pg8::cvt_pk_bf16; using pg8::u32x4;
typedef unsigned u32x2 __attribute__((ext_vector_type(2)));
__device__ __forceinline__ float wave_sum(float v) {
#pragma unroll
    for (int o = 1; o < 64; o <<= 1) v += __shfl_xor(v, o);
    return v;
}
__device__ __forceinline__ float bf2f(unsigned short h) { return __builtin_bit_cast(float, (unsigned)h << 16); }
__device__ __forceinline__ float bflo(unsigned w) { return __builtin_bit_cast(float, w << 16); }
__device__ __forceinline__ float bfhi(unsigned w) { return __builtin_bit_cast(float, w & 0xffff0000u); }
__device__ __forceinline__ void st8(bf16* p, f32x4 a, f32x4 b) {
    u32x4 w; w.x = cvt_pk_bf16(a[0], a[1]); w.y = cvt_pk_bf16(a[2], a[3]); w.z = cvt_pk_bf16(b[0], b[1]); w.w = cvt_pk_bf16(b[2], b[3]); *(u32x4*)p = w; }
__device__ __forceinline__ float silu_f(float x) { return x * __builtin_amdgcn_rcpf(1.0f + __builtin_amdgcn_exp2f(-1.4426950408889634f * x)); }
__device__ __forceinline__ f32x4 silu4(f32x4 x) { return (f32x4){silu_f(x[0]), silu_f(x[1]), silu_f(x[2]), silu_f(x[3])}; }
__device__ __forceinline__ float ret_lg(int h) { return __builtin_log2f(1.0f - __builtin_amdgcn_exp2f(-5.0f - (float)h)); }

struct EpiInProj {
    static constexpr bool PERM = true, AFTER_DRAIN = false;
    unsigned char* wsb; const float *qg, *kg;
    __device__ __forceinline__ void operator()(const f32x4 (&acc)[2][2][4][2], const Unit& u, int wr, int wc, int fr, int fq) const {
        const int pn = u.pn, row0 = u.pm * pg8::BM + wr * 64 + fr;
        if (pn < 4) {
            const bool isq = pn < 2; const float* gp = isq ? qg : kg; bf16* dst = (bf16*)(wsb + (isq ? WS_Q : WS_K)); const float sc = isq ? 0.125f : 1.0f;
            const int head = 4 * (pn & 1) + wc;
            f32x4 gv[2][2];
#pragma unroll
            for (int bj = 0; bj < 2; ++bj)
#pragma unroll
                for (int n = 0; n < 2; ++n) gv[bj][n] = *(const f32x4*)(gp + 32 * bj + 8 * fq + 4 * n);
#pragma unroll
            for (int ai = 0; ai < 2; ++ai)
#pragma unroll
                for (int m = 0; m < 4; ++m) {
                    float ss = 0.f;
#pragma unroll
                    for (int bj = 0; bj < 2; ++bj)
#pragma unroll
                        for (int n = 0; n < 2; ++n) { const f32x4 x = acc[ai][bj][m][n]; ss += (x[0] * x[0] + x[1] * x[1]) + (x[2] * x[2] + x[3] * x[3]); }
                    ss += __shfl_xor(ss, 16); ss += __shfl_xor(ss, 32);
                    const float r = __builtin_amdgcn_rsqf(ss * (1.0f / 64.0f) + EPS) * sc;
                    bf16* rp = dst + (size_t)(row0 + ai * pg8::HALF + m * 16) * AW + head * 64 + 8 * fq;
#pragma unroll
                    for (int bj = 0; bj < 2; ++bj) st8(rp + 32 * bj, acc[ai][bj][m][0] * r * gv[bj][0], acc[ai][bj][m][1] * r * gv[bj][1]);
                }
        } else if (pn == 6 || pn == 7) {
            const bool isq = pn == 6; bf16* dst = (bf16*)(wsb + (isq ? WS_RQ : WS_RK)); const int head = wc; const float lg = ret_lg(head);
            const float* cosT = (const float*)(wsb + WS_ROPE); const float* sinT = cosT + SEQ * 32;
#pragma unroll
            for (int ai = 0; ai < 2; ++ai)
#pragma unroll
                for (int m = 0; m < 4; ++m) {
                    const int row = row0 + ai * pg8::HALF + m * 16, pos = row & (SEQ - 1); const float p = (float)(pos & 127);
                    const float sc = isq ? 0.125f * __builtin_amdgcn_exp2f(p * lg) : __builtin_amdgcn_exp2f(-p * lg);
                    const float* cp = cosT + pos * 32 + 8 * fq; const float* sp = sinT + pos * 32 + 8 * fq;
                    const f32x4 c0 = *(const f32x4*)cp, c1 = *(const f32x4*)(cp + 4), s0 = *(const f32x4*)sp, s1 = *(const f32x4*)(sp + 4);
                    const f32x4 a0 = acc[ai][0][m][0], a1 = acc[ai][0][m][1], b0 = acc[ai][1][m][0], b1 = acc[ai][1][m][1];
                    bf16* rp = dst + (size_t)row * 256 + head * 64 + 8 * fq;
                    st8(rp, (a0 * c0 - b0 * s0) * sc, (a1 * c1 - b1 * s1) * sc);
                    st8(rp + 32, (a0 * s0 + b0 * c0) * sc, (a1 * s1 + b1 * c1) * sc);
                }
        } else {
            size_t doff; int col0;
            if (pn < 6) { doff = WS_V; col0 = (pn - 4) * 256; } else if (pn < 10) { doff = WS_RV; col0 = (pn - 8) * 256; } else { doff = WS_RG; col0 = (pn - 10) * 256; }
            bf16* dst = (bf16*)(wsb + doff);
            col0 += wc * 32 + 8 * fq;
#pragma unroll
            for (int ai = 0; ai < 2; ++ai)
#pragma unroll
                for (int m = 0; m < 4; ++m) { bf16* rp = dst + (size_t)(row0 + ai * pg8::HALF + m * 16) * 512 + col0;
#pragma unroll
                    for (int bj = 0; bj < 2; ++bj) st8(rp + bj * pg8::HALF, acc[ai][bj][m][0], acc[ai][bj][m][1]); }
        }
    }
};
struct EpiResid {
    static constexpr bool PERM = false, AFTER_DRAIN = false;
    const float* base; float* out; const float* gate;
    __device__ __forceinline__ void operator()(const f32x4 (&acc)[2][2][4][2], const Unit& u, int wr, int wc, int fr, int fq) const {
        const int row0 = u.pm * pg8::BM + wr * 64 + fr, col0 = u.pn * pg8::BM + wc * 32 + 4 * fq, b = u.pm >> 3;
        f32x4 gv[2][2];
#pragma unroll
        for (int bj = 0; bj < 2; ++bj)
#pragma unroll
            for (int n = 0; n < 2; ++n) gv[bj][n] = *(const f32x4*)(gate + (size_t)b * MODW + col0 + bj * pg8::HALF + n * 16);
#pragma unroll
        for (int ai = 0; ai < 2; ++ai)
#pragma unroll
            for (int m = 0; m < 4; ++m) { const size_t off = (size_t)(row0 + ai * pg8::HALF + m * 16) * D + col0;
#pragma unroll
                for (int bj = 0; bj < 2; ++bj)
#pragma unroll
                    for (int n = 0; n < 2; ++n) { const f32x4 xv = *(const f32x4*)(base + off + bj * pg8::HALF + n * 16); *(f32x4*)(out + off + bj * pg8::HALF + n * 16) = xv + gv[bj][n] * acc[ai][bj][m][n]; } }
    }
};
struct EpiSwiglu {
    static constexpr bool PERM = true, AFTER_DRAIN = false;
    bf16* Hd; int ldh, ntn;
    __device__ __forceinline__ void operator()(const f32x4 (&acc)[2][2][4][2], const Unit& u, int wr, int wc, int fr, int fq) const {
        const int pnl = u.pn % ntn, row0 = u.pm * pg8::BM + wr * 64 + fr, col0 = pnl * 128 + wc * 32 + 8 * fq;
#pragma unroll
        for (int ai = 0; ai < 2; ++ai)
#pragma unroll
            for (int m = 0; m < 4; ++m)
                st8(Hd + (size_t)(row0 + ai * pg8::HALF + m * 16) * ldh + col0, silu4(acc[ai][0][m][0]) * acc[ai][1][m][0], silu4(acc[ai][0][m][1]) * acc[ai][1][m][1]);
    }
};
struct EpiMoe2 {
    static constexpr bool PERM = true, AFTER_DRAIN = false;
    bf16* Y; const float* slot_w;
    __device__ __forceinline__ void operator()(const f32x4 (&acc)[2][2][4][2], const Unit& u, int wr, int wc, int fr, int fq) const {
        const int pnl = u.pn & 3, row0 = u.pm * pg8::BM + wr * 64 + fr, col0 = pnl * 256 + wc * 32 + 8 * fq;
#pragma unroll
        for (int ai = 0; ai < 2; ++ai)
#pragma unroll
            for (int m = 0; m < 4; ++m) { const int row = row0 + ai * pg8::HALF + m * 16; const float w = slot_w[row];
#pragma unroll
                for (int bj = 0; bj < 2; ++bj) st8(Y + (size_t)row * D + col0 + bj * pg8::HALF, acc[ai][bj][m][0] * w, acc[ai][bj][m][1] * w); }
    }
};
struct MoeOrder {
    int t0, t1, t2, t3, t4, t5, t6, t7, t8; int ntn, G, c;
    __device__ __forceinline__ void init(const unsigned* cnt, int ntn_, int G_, int c_) {
        ntn = ntn_; G = G_; c = c_;
        t0 = 0; t1 = t0 + (int)((cnt[0] + 255u) >> 8); t2 = t1 + (int)((cnt[64] + 255u) >> 8); t3 = t2 + (int)((cnt[128] + 255u) >> 8); t4 = t3 + (int)((cnt[192] + 255u) >> 8);
        t5 = t4 + (int)((cnt[256] + 255u) >> 8); t6 = t5 + (int)((cnt[320] + 255u) >> 8); t7 = t6 + (int)((cnt[384] + 255u) >> 8); t8 = t7 + (int)((cnt[448] + 255u) >> 8);
    }
    __device__ __forceinline__ bool next(int i, Unit& u) const {
        const int L = i * G + c; if (L >= t8 * ntn) return false;
        int e = 0, lo = 0, hi = t1;
        if (L >= t1 * ntn) { e = 1; lo = t1; hi = t2; }
        if (L >= t2 * ntn) { e = 2; lo = t2; hi = t3; }
        if (L >= t3 * ntn) { e = 3; lo = t3; hi = t4; }
        if (L >= t4 * ntn) { e = 4; lo = t4; hi = t5; }
        if (L >= t5 * ntn) { e = 5; lo = t5; hi = t6; }
        if (L >= t6 * ntn) { e = 6; lo = t6; hi = t7; }
        if (L >= t7 * ntn) { e = 7; lo = t7; hi = t8; }
        const int te = hi - lo, loc = L - lo * ntn, j = loc / te, r = loc - j * te;
        u.pm = lo + r; u.pn = e * ntn + j; return true;
    }
    __device__ __forceinline__ void a_ready(const Unit&) const {}
    __device__ __forceinline__ void done(const Unit&) const {}
};

struct Frame { LAS unsigned char* lds; int tid, lane, wave, G, bid; };
__device__ __forceinline__ Frame phase_frame(const Frame& F) { Frame f = F; asm volatile("" : "+v"(f.tid)); f.lane = f.tid & 63; return f; }

__device__ __forceinline__ void transpose_item(const float* W, int K, int N, bf16* WT, int drow0, LAS float* scr, int k0, int n0, int lane) {
#pragma unroll 8
    for (int i = 0; i < 32; ++i) { const int kk = 2 * i + (lane >> 5); scr[kk * 33 + (lane & 31)] = W[(size_t)(k0 + kk) * N + n0 + (lane & 31)]; }
    LDS_WAIT(); asm volatile("" ::: "memory");
    const int c = lane & 7;
#pragma unroll
    for (int j = 0; j < 4; ++j) { const int n = (lane >> 3) + 8 * j; const LAS float* s = scr + (8 * c) * 33 + n;
        v4u o; o.x = pk2(s[0 * 33], s[1 * 33]); o.y = pk2(s[2 * 33], s[3 * 33]); o.z = pk2(s[4 * 33], s[5 * 33]); o.w = pk2(s[6 * 33], s[7 * 33]);
        *(GAS v4u*)(WT + (size_t)(drow0 + n) * K + k0 + 8 * c) = o; }
    LDS_WAIT(); asm volatile("" ::: "memory");
}
__device__ __forceinline__ int inproj_dst_row(int n0) {
    const int pn = n0 >> 8, c = n0 & 255;
    const bool perm = (pn < 4) || pn == 6 || pn == 7;
    if (!perm) return n0;
    return (pn << 8) + 128 * ((c >> 5) & 1) + 32 * (c >> 6);
}
__device__ __forceinline__ int swiglu_dst_row(int n0, int second) { return 256 * (n0 >> 7) + (n0 & 127) + 128 * second; }

struct Ptrs {
    const float *x, *c, *bias_tab, *norm_mix, *norm_ffn, *w_mod, *b_mod, *w_in, *q_gain, *k_gain, *ret_gain, *w_out, *ffn_w1, *ffn_w3, *ffn_w2, *router, *moe_w1, *moe_w3, *moe_w2;
    float* out; unsigned char* ws;
};

__device__ __forceinline__ void p0_prologue(const Frame& F, const Ptrs& P) {
    unsigned char* ws = P.ws;
    {
        LAS float* cact = (LAS float*)(F.lds);
        LAS float* red = (LAS float*)(F.lds + 32768);
        for (int i = F.tid; i < BATCH * D; i += NTHR) { const int b = i >> 10, k = i & 1023; cact[k * 8 + b] = silu_f(P.c[i]); }
        __syncthreads();
        float* MOD = (float*)(ws + WS_MOD);
        for (int it = F.bid; it < 2 * (MODW / 64); it += F.G) {
            const int l = it / (MODW / 64), cc = it % (MODW / 64), col = cc * 64 + F.lane;
            const float* Wp = P.w_mod + (size_t)l * D * MODW + col;
            float a[8];
#pragma unroll
            for (int b = 0; b < 8; ++b) a[b] = 0.f;
            const int kb = F.wave * 128;
#pragma unroll 8
            for (int k = 0; k < 128; ++k) { const float w = Wp[(size_t)(kb + k) * MODW]; const f32x4 c0 = *(const LAS f32x4*)(cact + (kb + k) * 8), c1 = *(const LAS f32x4*)(cact + (kb + k) * 8 + 4);
                a[0] += c0[0] * w; a[1] += c0[1] * w; a[2] += c0[2] * w; a[3] += c0[3] * w; a[4] += c1[0] * w; a[5] += c1[1] * w; a[6] += c1[2] * w; a[7] += c1[3] * w; }
#pragma unroll
            for (int b = 0; b < 8; ++b) red[(F.wave * 8 + b) * 64 + F.lane] = a[b];
            __syncthreads();
            { const int b = F.wave, ln = F.lane; float s = 0.f;
#pragma unroll
              for (int w = 0; w < 8; ++w) s += red[(w * 8 + b) * 64 + ln];
              MOD[(size_t)l * BATCH * MODW + (size_t)b * MODW + cc * 64 + ln] = s + P.b_mod[l * MODW + cc * 64 + ln]; }
            __syncthreads();
        }
    }
    {
        float* cosT = (float*)(ws + WS_ROPE); float* sinT = cosT + SEQ * 32;
        for (int i = F.bid * NTHR + F.tid; i < SEQ * 32; i += F.G * NTHR) { const int pos = i >> 5, j = i & 31;
            const float inv = powf(10000.0f, -(float)j / 32.0f), ang = (float)pos * inv; float s, c; sincosf(ang, &s, &c); cosT[i] = c; sinT[i] = s; }
    }
    {
        LAS float* scr = (LAS float*)(F.lds + F.wave * 16384);
        const int gw = F.bid * NWAVES + F.wave, NGW = F.G * NWAVES;
        constexpr int I_IN = 16 * 96, I_OUT = 16 * 32, I_F13 = 16 * 88, I_F2 = 44 * 32, I_M13 = 16 * 112, I_M2 = 56 * 32;
        constexpr int B0 = 0, B1 = B0 + 2 * I_IN, B2 = B1 + 2 * I_OUT, B3 = B2 + 2 * I_F13, B4 = B3 + I_F2, B5 = B4 + 16 * I_M13, NITEMS = B5 + 8 * I_M2;
        __syncthreads();
        for (int it = gw; it < NITEMS; it += NGW) {
            if (it < B1) { const int l = it / I_IN, r = it % I_IN, kb = r / 96, nb = r % 96;
                transpose_item(P.w_in + (size_t)l * D * NIN, D, NIN, (bf16*)(ws + WS_WIN) + (size_t)l * NIN * D, inproj_dst_row(32 * nb), scr, 64 * kb, 32 * nb, F.lane); }
            else if (it < B2) { const int q = it - B1, l = q / I_OUT, r = q % I_OUT, kb = r / 32, nb = r % 32;
                transpose_item(P.w_out + (size_t)l * D * D, D, D, (bf16*)(ws + WS_WOUT) + (size_t)l * D * D, 32 * nb, scr, 64 * kb, 32 * nb, F.lane); }
            else if (it < B3) { const int q = it - B2, second = q / I_F13, r = q % I_F13, kb = r / 88, nb = r % 88;
                transpose_item(second ? P.ffn_w3 : P.ffn_w1, D, DFF, (bf16*)(ws + WS_F13), swiglu_dst_row(32 * nb, second), scr, 64 * kb, 32 * nb, F.lane); }
            else if (it < B4) { const int r = it - B3, kb = r / 32, nb = r % 32;
                transpose_item(P.ffn_w2, DFF, D, (bf16*)(ws + WS_F2), 32 * nb, scr, 64 * kb, 32 * nb, F.lane); }
            else if (it < B5) { const int q = it - B4, me = q / I_M13, second = me >> 3, e = me & 7, r = q % I_M13, kb = r / 112, nb = r % 112;
                transpose_item((second ? P.moe_w3 : P.moe_w1) + (size_t)e * D * DFE, D, DFE, (bf16*)(ws + WS_MOE13) + (size_t)e * 2 * DFE * D, swiglu_dst_row(32 * nb, second), scr, 64 * kb, 32 * nb, F.lane); }
            else { const int q = it - B5, e = q / I_M2, r = q % I_M2, kb = r / 32, nb = r % 32;
                transpose_item(P.moe_w2 + (size_t)e * DFE * D, DFE, D, (bf16*)(ws + WS_MOE2) + (size_t)e * D * DFE, 32 * nb, scr, 64 * kb, 32 * nb, F.lane); }
        }
    }
}

__device__ __forceinline__ void norm_row(const float* xrow, const float* gain, const float* scp, const float* shp, bf16* orow, int lane, f32x4 (&hv)[4]) {
    const GAS f32x4* xr = (const GAS f32x4*)xrow + lane;
    f32x4 v[4]; float s = 0.f;
#pragma unroll
    for (int j = 0; j < 4; ++j) { v[j] = xr[64 * j]; s += (v[j].x * v[j].x + v[j].y * v[j].y) + (v[j].z * v[j].z + v[j].w * v[j].w); }
    const float rstd = 1.0f / sqrtf(wave_sum(s) * (1.0f / D) + EPS);
    GAS u32x2* o8 = (GAS u32x2*)orow + lane;
#pragma unroll
    for (int j = 0; j < 4; ++j) { const f32x4 g = *((const GAS f32x4*)gain + lane + 64 * j), sc = *((const GAS f32x4*)scp + lane + 64 * j), sh = *((const GAS f32x4*)shp + lane + 64 * j);
        const f32x4 o = (v[j] * rstd) * g * (sc + 1.0f) + sh; hv[j] = o;
        u32x2 w; w.x = cvt_pk_bf16(o[0], o[1]); w.y = cvt_pk_bf16(o[2], o[3]); o8[64 * j] = w; }
}
__device__ __forceinline__ void norm_phase(const Frame& F, const float* xin, const float* gain, const float* modl, int ch_shift, int ch_scale, bf16* H) {
    const int gw = F.bid * NWAVES + F.wave, NGW = F.G * NWAVES;
    for (int m = gw; m < M; m += NGW) { const int b = m >> 11; f32x4 hv[4];
        norm_row(xin + (size_t)m * D, gain, modl + (size_t)b * MODW + ch_scale * D, modl + (size_t)b * MODW + ch_shift * D, H + (size_t)m * D, F.lane, hv); }
}
__device__ __forceinline__ void norm_router_phase(const Frame& F, const float* xin, const float* gain, const float* modl, int ch_shift, int ch_scale, bf16* H,
                                                  const float* router, int* tok_e, float* tok_w, int* tok_slot, unsigned* cnt) {
    LAS float* RT = (LAS float*)(F.lds);
    LAS int* lcnt = (LAS int*)(F.lds + 32768);
    LAS int* basee = (LAS int*)(F.lds + 32768 + 64);
    LAS int* rinfo = (LAS int*)(F.lds + 32768 + 128);
    for (int i = F.tid; i < D * NE; i += NTHR) { const int k = i >> 3, e = i & 7; RT[e * D + k] = router[i]; }
    __syncthreads();
    for (int rb = F.bid; rb < M / 64; rb += F.G) {
        if (F.tid < 8) lcnt[F.tid] = 0;
        __syncthreads();
        for (int rr = 0; rr < 8; ++rr) {
            const int lr = F.wave * 8 + rr, m = rb * 64 + lr, b = m >> 11; f32x4 hv[4];
            norm_row(xin + (size_t)m * D, gain, modl + (size_t)b * MODW + ch_scale * D, modl + (size_t)b * MODW + ch_shift * D, H + (size_t)m * D, F.lane, hv);
            float lg[8];
#pragma unroll
            for (int e = 0; e < 8; ++e) { float a = 0.f;
#pragma unroll
                for (int j = 0; j < 4; ++j) { const f32x4 r = *((const LAS f32x4*)(RT + e * D) + F.lane + 64 * j); a += (hv[j][0] * r[0] + hv[j][1] * r[1]) + (hv[j][2] * r[2] + hv[j][3] * r[3]); }
                lg[e] = wave_sum(a); }
            int e1 = 0; float v1 = lg[0];
#pragma unroll
            for (int e = 1; e < 8; ++e) if (lg[e] > v1) { v1 = lg[e]; e1 = e; }
            int e2 = -1; float v2 = -3.0e38f;
#pragma unroll
            for (int e = 0; e < 8; ++e) if (e != e1 && lg[e] > v2) { v2 = lg[e]; e2 = e; }
            if (F.lane == 0) {
                const float w1 = 1.0f / (1.0f + expf(v2 - v1));
                const int l1 = atomicAdd((int*)&lcnt[e1], 1), l2 = atomicAdd((int*)&lcnt[e2], 1);
                rinfo[lr * 4 + 0] = e1; rinfo[lr * 4 + 1] = l1; rinfo[lr * 4 + 2] = e2; rinfo[lr * 4 + 3] = l2;
                tok_e[2 * m] = e1; tok_e[2 * m + 1] = e2; tok_w[2 * m] = w1; tok_w[2 * m + 1] = 1.0f - w1;
            }
        }
        __syncthreads();
        if (F.tid < 8) basee[F.tid] = (int)__hip_atomic_fetch_add(cnt + 64 * F.tid, (unsigned)lcnt[F.tid], __ATOMIC_RELAXED, __HIP_MEMORY_SCOPE_AGENT);
        __syncthreads();
        if (F.tid < 64) { const int m = rb * 64 + F.tid; const int e1 = rinfo[F.tid * 4], l1 = rinfo[F.tid * 4 + 1], e2 = rinfo[F.tid * 4 + 2], l2 = rinfo[F.tid * 4 + 3];
            tok_slot[2 * m] = basee[e1] + l1; tok_slot[2 * m + 1] = basee[e2] + l2; }
        __syncthreads();
    }
}
__device__ __forceinline__ void map_phase(const Frame& F, const unsigned* cnt, const int* tok_e, const float* tok_w, const int* tok_slot, int* tok_dst, int* sorted_tok, float* slot_w) {
    int c[8], off[9]; off[0] = 0;
#pragma unroll
    for (int e = 0; e < 8; ++e) { c[e] = (int)cnt[64 * e]; off[e + 1] = off[e] + ((c[e] + 255) & ~255); }
    const int gt = F.bid * NTHR + F.tid, NT = F.G * NTHR;
    for (int i = gt; i < 2 * M; i += NT) { const int e = tok_e[i]; int o = 0;
#pragma unroll
        for (int k = 0; k < 8; ++k) o = (e == k) ? off[k] : o;
        const int dst = o + tok_slot[i]; tok_dst[i] = dst; sorted_tok[dst] = i >> 1; slot_w[dst] = tok_w[i]; }
    for (int i = gt; i < 8 * 256; i += NT) { const int e = i >> 8, r = i & 255; int o = 0, ce = 0, oe = 0;
#pragma unroll
        for (int k = 0; k < 8; ++k) { o = (e == k) ? off[k] : o; ce = (e == k) ? c[k] : ce; oe = (e == k) ? off[k + 1] : oe; }
        const int p = o + ce + r; if (p < oe) { sorted_tok[p] = 0; slot_w[p] = 0.f; } }
}
__device__ __forceinline__ void combine_phase(const Frame& F, float* x, const float* gate, const bf16* Y, const int* tok_dst) {
    const int gw = F.bid * NWAVES + F.wave, NGW = F.G * NWAVES;
    for (int m = gw; m < M; m += NGW) { const int b = m >> 11; const int d0 = tok_dst[2 * m], d1 = tok_dst[2 * m + 1];
        GAS f32x4* xr = (GAS f32x4*)(x + (size_t)m * D) + F.lane; const GAS u32x2* y0 = (const GAS u32x2*)(Y + (size_t)d0 * D) + F.lane; const GAS u32x2* y1 = (const GAS u32x2*)(Y + (size_t)d1 * D) + F.lane;
        const GAS f32x4* gp = (const GAS f32x4*)(gate + (size_t)b * MODW) + F.lane;
#pragma unroll
        for (int j = 0; j < 4; ++j) { const f32x4 xv = xr[64 * j], g = gp[64 * j]; const u32x2 a = y0[64 * j], bq = y1[64 * j];
            const f32x4 ys = (f32x4){bflo(a.x) + bflo(bq.x), bfhi(a.x) + bfhi(bq.x), bflo(a.y) + bflo(bq.y), bfhi(a.y) + bfhi(bq.y)};
            xr[64 * j] = xv + g * ys; }
    }
}

__global__ void __launch_bounds__(256) naive_attn(const bf16* __restrict__ Q, const bf16* __restrict__ Kb, const bf16* __restrict__ V, const float* __restrict__ bias_tab, bf16* __restrict__ MIX) {
    const int idx = blockIdx.x * 256 + threadIdx.x, head = idx & 7, tok = idx >> 3, b = tok >> 11, t = tok & (SEQ - 1);
    float q[64], acc[64];
    { const u32x4* qp = (const u32x4*)(Q + (size_t)tok * AW + head * 64);
#pragma unroll
      for (int i = 0; i < 8; ++i) { const u32x4 w = qp[i]; q[8 * i] = bflo(w.x); q[8 * i + 1] = bfhi(w.x); q[8 * i + 2] = bflo(w.y); q[8 * i + 3] = bfhi(w.y); q[8 * i + 4] = bflo(w.z); q[8 * i + 5] = bfhi(w.z); q[8 * i + 6] = bflo(w.w); q[8 * i + 7] = bfhi(w.w); } }
#pragma unroll
    for (int i = 0; i < 64; ++i) acc[i] = 0.f;
    float mx = -3.0e38f, l = 0.f;
    for (int br = 0; br < 3; ++br) { const int d = br == 0 ? 1 : (br == 1 ? 4 : 16);
        for (int dl = 0; dl <= 128; ++dl) { const int tk = t - dl * d; if (tk < 0) break;
            const size_t ro = (size_t)(b * SEQ + tk) * AW + head * 64; const u32x4* kp = (const u32x4*)(Kb + ro); const u32x4* vp = (const u32x4*)(V + ro);
            float s = 0.f;
#pragma unroll
            for (int i = 0; i < 8; ++i) { const u32x4 w = kp[i]; s += q[8 * i] * bflo(w.x) + q[8 * i + 1] * bfhi(w.x) + q[8 * i + 2] * bflo(w.y) + q[8 * i + 3] * bfhi(w.y) + q[8 * i + 4] * bflo(w.z) + q[8 * i + 5] * bfhi(w.z) + q[8 * i + 6] * bflo(w.w) + q[8 * i + 7] * bfhi(w.w); }
            s += bias_tab[(int)T5_BUCKET[br][dl] * NHEAD + head];
            if (s > mx) { const float sc = expf(mx - s); l *= sc;
#pragma unroll
                for (int i = 0; i < 64; ++i) acc[i] *= sc;
                mx = s; }
            const float p = expf(s - mx); l += p;
#pragma unroll
            for (int i = 0; i < 8; ++i) { const u32x4 w = vp[i]; acc[8 * i] += p * bflo(w.x); acc[8 * i + 1] += p * bfhi(w.x); acc[8 * i + 2] += p * bflo(w.y); acc[8 * i + 3] += p * bfhi(w.y); acc[8 * i + 4] += p * bflo(w.z); acc[8 * i + 5] += p * bfhi(w.z); acc[8 * i + 6] += p * bflo(w.w); acc[8 * i + 7] += p * bfhi(w.w); }
        } }
    const float il = 1.0f / l; u32x4* op = (u32x4*)(MIX + (size_t)tok * D + head * 64);
#pragma unroll
    for (int i = 0; i < 8; ++i) { u32x4 w; w.x = cvt_pk_bf16(acc[8 * i] * il, acc[8 * i + 1] * il); w.y = cvt_pk_bf16(acc[8 * i + 2] * il, acc[8 * i + 3] * il); w.z = cvt_pk_bf16(acc[8 * i + 4] * il, acc[8 * i + 5] * il); w.w = cvt_pk_bf16(acc[8 * i + 6] * il, acc[8 * i + 7] * il); op[i] = w; }
}
__global__ void __launch_bounds__(128) naive_ret(const bf16* __restrict__ RQ, const bf16* __restrict__ RK, const bf16* __restrict__ RV, const bf16* __restrict__ RG, const float* __restrict__ ret_gain, bf16* __restrict__ MIX) {
    __shared__ float sred[4];
    const int bh = blockIdx.x, b = bh >> 2, h = bh & 3, dv = threadIdx.x, wv = dv >> 6;
    float st[64];
#pragma unroll
    for (int i = 0; i < 64; ++i) st[i] = 0.f;
    const float g128 = __builtin_amdgcn_exp2f(128.0f * ret_lg(h)), gn = ret_gain[h * RDV + dv];
    for (int t = 0; t < SEQ; ++t) { const size_t row = (size_t)b * SEQ + t;
        if ((t & 127) == 0 && t) {
#pragma unroll
            for (int i = 0; i < 64; ++i) st[i] *= g128; }
        const u32x4* kp = (const u32x4*)(RK + row * 256 + h * 64); const u32x4* qp = (const u32x4*)(RQ + row * 256 + h * 64);
        const float v = bf2f(RV[row * 512 + h * RDV + dv]), gt = bf2f(RG[row * 512 + h * RDV + dv]);
        float y = 0.f;
#pragma unroll
        for (int i = 0; i < 8; ++i) { const u32x4 kw = kp[i], qw = qp[i];
            st[8 * i] += bflo(kw.x) * v; y += bflo(qw.x) * st[8 * i]; st[8 * i + 1] += bfhi(kw.x) * v; y += bfhi(qw.x) * st[8 * i + 1];
            st[8 * i + 2] += bflo(kw.y) * v; y += bflo(qw.y) * st[8 * i + 2]; st[8 * i + 3] += bfhi(kw.y) * v; y += bfhi(qw.y) * st[8 * i + 3];
            st[8 * i + 4] += bflo(kw.z) * v; y += bflo(qw.z) * st[8 * i + 4]; st[8 * i + 5] += bfhi(kw.z) * v; y += bfhi(qw.z) * st[8 * i + 5];
            st[8 * i + 6] += bflo(kw.w) * v; y += bflo(qw.w) * st[8 * i + 6]; st[8 * i + 7] += bfhi(kw.w) * v; y += bfhi(qw.w) * st[8 * i + 7]; }
        float s1 = wave_sum(y); if ((dv & 63) == 0) sred[wv] = s1; __syncthreads(); const float mu = (sred[0] + sred[1]) * (1.0f / RDV);
        const float dd = y - mu; float s2 = wave_sum(dd * dd); if ((dv & 63) == 0) sred[2 + wv] = s2; __syncthreads(); const float var = (sred[2] + sred[3]) * (1.0f / RDV);
        const float o = dd * (1.0f / sqrtf(var + EPS)) * gn * silu_f(gt);
        MIX[row * D + AW + h * RDV + dv] = (bf16)f2bf(o);
        __syncthreads();
    }
}

#ifndef SITE_MASK
#define SITE_MASK 63
#endif
constexpr int PH_PRO = 0, PH_PER_LAYER = 10, NPH = 1 + 2 * PH_PER_LAYER;
struct Args { const float* in[19]; float* out; unsigned char* ws; int ph_lo, ph_hi, li, pad; };
__global__ void __launch_bounds__(NTHR, 2) fwd(Args args) {
    extern __shared__ __attribute__((aligned(16))) unsigned char lds[];
    Frame F; F.lds = (LAS unsigned char*)lds; F.tid = threadIdx.x; F.lane = F.tid & 63; F.wave = __builtin_amdgcn_readfirstlane(F.tid >> 6); F.G = gridDim.x; F.bid = blockIdx.x;
    volatile LAS unsigned* MISC = (volatile LAS unsigned*)(F.lds + MISC_OFF);
    Ptrs P; P.x = args.in[0]; P.c = args.in[1]; P.bias_tab = args.in[2]; P.norm_mix = args.in[3]; P.norm_ffn = args.in[4]; P.w_mod = args.in[5]; P.b_mod = args.in[6]; P.w_in = args.in[7];
    P.q_gain = args.in[8]; P.k_gain = args.in[9]; P.ret_gain = args.in[10]; P.w_out = args.in[11]; P.ffn_w1 = args.in[12]; P.ffn_w3 = args.in[13]; P.ffn_w2 = args.in[14]; P.router = args.in[15];
    P.moe_w1 = args.in[16]; P.moe_w3 = args.in[17]; P.moe_w2 = args.in[18]; P.out = args.out; P.ws = args.ws;
    unsigned char* ws = args.ws; gu32* ctl = (gu32*)(ws + WS_CTL);
    for (int u = F.tid; u < (LDS_BYTES - LDSCTL_OFF) / 4; u += NTHR) ((LAS unsigned*)(F.lds + LDSCTL_OFF))[u] = 0u;
    __syncthreads();
    XcdBarrier bar = xcd_barrier_post((unsigned*)(ctl + CW_BAR) + args.li * XCD_BAR_WORDS, MISC + 8);
    const int lo = args.ph_lo, hi = args.ph_hi;
#define IN(k) (lo <= (k) && (k) < hi)
#define SEAM(k) do { if (IN(k) && (k) + 1 < hi) xcd_barrier(bar); } while (0)

    if (IN(PH_PRO)) { p0_prologue(phase_frame(F), P); } SEAM(PH_PRO);

    float* MOD = (float*)(ws + WS_MOD);
    for (int l = 0; l < 2; ++l) {
        const int pb = 1 + l * PH_PER_LAYER;
        const float* modl = MOD + (size_t)l * BATCH * MODW;
        const float* xin = l == 0 ? P.x : (const float*)P.out;
        if (IN(pb + 0)) norm_phase(phase_frame(F), xin, P.norm_mix + l * D, modl, 0, 1, (bf16*)(ws + WS_H));
        SEAM(pb + 0);
        if (IN(pb + 1)) {
            pg8::Gemm g{(const bf16*)(ws + WS_H), (const bf16*)(ws + WS_WIN) + (size_t)l * NIN * D, M, NIN, D, nullptr}; pg8::StaticOrder S; S.init(M, NIN, F.G, F.bid);
            EpiInProj E{ws, P.q_gain + l * HD, P.k_gain + l * HD};

#if SITE_MASK & 1
pg8::gemm_phase<EpiInProj, pg8::StaticOrder, false>(F.lds + RING_OFF, g, S, E);
#endif

        }
        SEAM(pb + 1);
        SEAM(pb + 2);
        SEAM(pb + 3);
        if (IN(pb + 4)) {
            pg8::Gemm g{(const bf16*)(ws + WS_MIXED), (const bf16*)(ws + WS_WOUT) + (size_t)l * D * D, M, D, D, nullptr}; pg8::StaticOrder S; S.init(M, D, F.G, F.bid);
            EpiResid E{xin, P.out, modl + 2 * D};

#if SITE_MASK & 2
pg8::gemm_phase<EpiResid, pg8::StaticOrder, false>(F.lds + RING_OFF, g, S, E);
#endif

        }
        SEAM(pb + 4);
        if (IN(pb + 5)) {
            if (l == 0) norm_phase(phase_frame(F), P.out, P.norm_ffn + l * D, modl, 3, 4, (bf16*)(ws + WS_H));
            else norm_router_phase(phase_frame(F), P.out, P.norm_ffn + l * D, modl, 3, 4, (bf16*)(ws + WS_H), P.router, (int*)(ws + TOK_E), (float*)(ws + TOK_W), (int*)(ws + TOK_SLOT), (unsigned*)(ctl + CW_CNT));
        }
        SEAM(pb + 5);
        if (l == 1) {
            if (IN(pb + 6)) map_phase(phase_frame(F), (const unsigned*)(ctl + CW_CNT), (const int*)(ws + TOK_E), (const float*)(ws + TOK_W), (const int*)(ws + TOK_SLOT), (int*)(ws + TOK_DST), (int*)(ws + SORTED_TOK), (float*)(ws + SLOT_W));
            SEAM(pb + 6);
        }
        if (IN(pb + 7)) {
            if (l == 0) {
                pg8::Gemm g{(const bf16*)(ws + WS_H), (const bf16*)(ws + WS_F13), M, 2 * DFF, D, nullptr}; pg8::StaticOrder S; S.init(M, 2 * DFF, F.G, F.bid);
                EpiSwiglu E{(bf16*)(ws + WS_HID), DFF, 2 * DFF / 256};

#if SITE_MASK & 4
pg8::gemm_phase<EpiSwiglu, pg8::StaticOrder, false>(F.lds + RING_OFF, g, S, E);
#endif

            } else {
                pg8::Gemm g{(const bf16*)(ws + WS_H), (const bf16*)(ws + WS_MOE13), MAXSLOT, 2 * DFE, D, (const int*)(ws + SORTED_TOK)}; MoeOrder S; S.init((const unsigned*)(ctl + CW_CNT), 2 * DFE / 256, F.G, F.bid);
                EpiSwiglu E{(bf16*)(ws + WS_HID), DFE, 2 * DFE / 256};

#if SITE_MASK & 8
pg8::gemm_phase<EpiSwiglu, MoeOrder, true>(F.lds + RING_OFF, g, S, E);
#endif

            }
        }
        SEAM(pb + 7);
        if (IN(pb + 8)) {
            if (l == 0) {
                pg8::Gemm g{(const bf16*)(ws + WS_HID), (const bf16*)(ws + WS_F2), M, D, DFF, nullptr}; pg8::StaticOrder S; S.init(M, D, F.G, F.bid);
                EpiResid E{P.out, P.out, modl + 5 * D};

#if SITE_MASK & 16
pg8::gemm_phase<EpiResid, pg8::StaticOrder, false>(F.lds + RING_OFF, g, S, E);
#endif

            } else {
                pg8::Gemm g{(const bf16*)(ws + WS_HID), (const bf16*)(ws + WS_MOE2), MAXSLOT, D, DFE, nullptr}; MoeOrder S; S.init((const unsigned*)(ctl + CW_CNT), D / 256, F.G, F.bid);
                EpiMoe2 E{(bf16*)(ws + WS_Y), (const float*)(ws + SLOT_W)};

#if SITE_MASK & 32
pg8::gemm_phase<EpiMoe2, MoeOrder, false>(F.lds + RING_OFF, g, S, E);
#endif

            }
        }
        if (l == 1) {
            SEAM(pb + 8);
            if (IN(pb + 9)) combine_phase(phase_frame(F), P.out, modl + 5 * D, (const bf16*)(ws + WS_Y), (const int*)(ws + TOK_DST));
        } else { SEAM(pb + 8); }
    }
#undef IN
#undef SEAM
}

extern "C" void kernel_launch(void* const* d_in, const int* in_sizes, int n_in, void* d_out, int out_size, void* d_ws, size_t ws_size, hipStream_t stream) {
    static int grid = 0;
    if (grid == 0) {
        if (n_in != 19 || in_sizes[0] != M * D || out_size != M * D || ws_size < WS_END) { fprintf(stderr, "kernel_launch: unexpected problem (n_in %d, ws %zu); nothing launched\n", n_in, ws_size); grid = -1; return; }
        int dev = 0, cus = 0, per_cu = 0;
        if (hipGetDevice(&dev) != hipSuccess || hipDeviceGetAttribute(&cus, hipDeviceAttributeMultiprocessorCount, dev) != hipSuccess) { grid = -1; return; }
        if (hipFuncSetAttribute((const void*)fwd, hipFuncAttributeMaxDynamicSharedMemorySize, LDS_BYTES) != hipSuccess) { grid = -1; return; }
        if (hipOccupancyMaxActiveBlocksPerMultiprocessor(&per_cu, (const void*)fwd, NTHR, LDS_BYTES) != hipSuccess || per_cu < 1) fprintf(stderr, "kernel_launch: occupancy query says %d\n", per_cu);
        (void)hipGetLastError();
        grid = cus;
    }
    if (grid < 0) return;
    (void)hipMemsetAsync((char*)d_ws + WS_CTL, 0, CTL_ZERO_BYTES, stream);
    Args a{};
    for (int i = 0; i < 19; ++i) a.in[i] = (const float*)d_in[i];
    a.out = (float*)d_out; a.ws = (unsigned char*)d_ws; a.pad = 0;
    unsigned char* ws = (unsigned char*)d_ws;
    int li = 0;
    auto run = [&](int plo, int phi) { a.ph_lo = plo; a.ph_hi = phi; a.li = li++; hipLaunchKernelGGL(fwd, dim3(grid), dim3(NTHR), LDS_BYTES, stream, a); };
    run(PH_PRO, PH_PRO + 1);
    for (int l = 0; l < 2; ++l) {
        const int pb = 1 + l * PH_PER_LAYER;
        run(pb + 0, pb + 1); run(pb + 1, pb + 2);
        hipLaunchKernelGGL(naive_attn, dim3(M * NHEAD / 256), dim3(256), 0, stream, (const bf16*)(ws + WS_Q), (const bf16*)(ws + WS_K), (const bf16*)(ws + WS_V), (const float*)d_in[2], (bf16*)(ws + WS_MIXED));
        hipLaunchKernelGGL(naive_ret, dim3(BATCH * RH), dim3(128), 0, stream, (const bf16*)(ws + WS_RQ), (const bf16*)(ws + WS_RK), (const bf16*)(ws + WS_RV), (const bf16*)(ws + WS_RG), (const float*)d_in[10] + l * AW, (bf16*)(ws + WS_MIXED));
        run(pb + 4, pb + 5); run(pb + 5, pb + 6);
        if (l == 1) run(pb + 6, pb + 7);
        run(pb + 7, pb + 8); run(pb + 8, pb + 9);
        if (l == 1) run(pb + 9, pb + 10);
    }
}
```

```cpp
#include <hip/hip_runtime.h>
#include <cstdio>
#include <cstdint>
#include <cmath>
namespace pg8 {
#define PG8_LAS __attribute__((address_space(3)))
typedef unsigned short bf16_t;
typedef short bf16x8 __attribute__((ext_vector_type(8)));
typedef float f32x4 __attribute__((ext_vector_type(4)));
typedef unsigned u32x4 __attribute__((ext_vector_type(4)));
constexpr int BM = 256, BK = 64, HALF = 128, HTB = HALF * BK * 2  , STAGE_BYTES = 8 * HTB, NXCD = 8, WGM = 8;

__host__ __device__ __forceinline__ int lds_byte(int r, int c) { const int st = (r >> 4) * 2 + (c >> 5), rr = r & 15, cc = c & 31, ob = rr * 64 + cc * 2; return st * 1024 + (ob ^ (((ob >> 9) & 1) << 5)); }
__host__ __device__ __forceinline__ void stage_rc(int b, int& R, int& C) { const int st = b / 1024, sb = b % 1024, swz = sb ^ (((sb >> 9) & 1) << 5); R = (st >> 1) * 16 + swz / 64; C = (st & 1) * 32 + (swz % 64) / 2; }
__host__ __device__ __forceinline__ int perm32(int rho) { const int n = rho >> 4, i = rho & 15; return 8 * (i >> 2) + 4 * n + (i & 3); }

struct Unit { int pm, pn; };
struct Gemm { const bf16_t* A; const bf16_t* Bt; int M, N, K; const int* rowidx; };

struct StaticOrder {
    int nM, nN, nwg, G, c;
    __host__ __device__ void init(int M, int N, int G_, int c_) { nM = M / BM; nN = N / BM; nwg = nM * nN; G = G_; c = c_; }
    __host__ __device__ bool next(int i, Unit& u) const {
        const long L = (long)i * G + c; if (L >= nwg) return false;
        int wgid = (int)L; { const int q = nwg / NXCD, r = nwg % NXCD, xcd = wgid % NXCD, off = wgid / NXCD; wgid = (xcd < r ? xcd * (q + 1) : r * (q + 1) + (xcd - r) * q) + off; }
        const int nig = WGM * nN, gid = wgid / nig, fm = gid * WGM, gsz = (nM - fm) < WGM ? (nM - fm) : WGM;
        u.pm = fm + ((wgid % nig) % gsz); u.pn = (wgid % nig) / gsz; return true;
    }
    __device__ __forceinline__ void a_ready(const Unit&) const {}
    __device__ __forceinline__ void done(const Unit&) const {}
};

__device__ __forceinline__ unsigned cvt_pk_bf16(float lo, float hi) { unsigned r; asm volatile("v_cvt_pk_bf16_f32 %0, %1, %2" : "=v"(r) : "v"(lo), "v"(hi)); return r; }
typedef float f32x2 __attribute__((ext_vector_type(2)));
template <class Epi, class Sched, bool GATHER>
__device__ __forceinline__ void gemm_phase(PG8_LAS unsigned char* lds, const Gemm g, const Sched& S, const Epi& E) {
    int tid_ = threadIdx.x; asm volatile("" : "+v"(tid_));
    const int tid = tid_, wid = __builtin_amdgcn_readfirstlane(tid >> 6), lane = tid & 63, wr = wid >> 2, wc = wid & 3, fr = lane & 15, fq = lane >> 4;
    const int K = g.K, nt = K / BK;
    const size_t kstep = (size_t)(BK * 2);
    const size_t hstep = (size_t)HALF * K * 2;
    const size_t tstep = 2 * hstep;
    int RA[2], CA2[2]; unsigned voffB[2];
#pragma unroll
    for (int i = 0; i < 2; ++i) { int R, C; stage_rc(tid * 16 + i * 8192, R, C); const int Rb = Epi::PERM ? ((R & ~31) + perm32(R & 31)) : R;
        RA[i] = R; CA2[i] = C * 2; voffB[i] = (unsigned)(Rb * K + C) * 2u; }
    unsigned cv00, cv01, cv10, cv11, nv00, nv01, nv10, nv11;
    const unsigned ldsw = (unsigned)wid * 1024u;
    const int aoff = lds_byte(wr * 64 + fr, fq * 8), boff = lds_byte(wc * 32 + fr, fq * 8);
#define PG8_SA(b, h) (((b) * 2 + (h)) * HTB)
#define PG8_SB(b, h) ((4 + (b) * 2 + (h)) * HTB)
#define PG8_STAGE(bufoff, gbase, voff) do { _Pragma("unroll") for (int _i = 0; _i < 2; ++_i) \
        __builtin_amdgcn_global_load_lds((const unsigned*)((const char*)(gbase) + (voff)[_i]), (PG8_LAS unsigned*)(lds + (bufoff) + ldsw + _i * 8192), 16, 0, 0); } while (0)
#define PG8_STAGEA(bufoff, gbase, v0, v1) do { \
        __builtin_amdgcn_global_load_lds((const unsigned*)((const char*)(gbase) + (v0)), (PG8_LAS unsigned*)(lds + (bufoff) + ldsw), 16, 0, 0); \
        __builtin_amdgcn_global_load_lds((const unsigned*)((const char*)(gbase) + (v1)), (PG8_LAS unsigned*)(lds + (bufoff) + ldsw + 8192), 16, 0, 0); } while (0)
#define PG8_LDA(dst, b, h) do { _Pragma("unroll") for (int m = 0; m < 4; ++m) _Pragma("unroll") for (int k = 0; k < 2; ++k) dst[m][k] = *(const PG8_LAS bf16x8*)(lds + PG8_SA(b, h) + aoff + m * 2048 + k * 1024); } while (0)
#define PG8_LDB(dst, b, h) do { _Pragma("unroll") for (int n = 0; n < 2; ++n) _Pragma("unroll") for (int k = 0; k < 2; ++k) dst[n][k] = *(const PG8_LAS bf16x8*)(lds + PG8_SB(b, h) + boff + n * 2048 + k * 1024); } while (0)
#define PG8_MMA(ai, bj, At, Bt) do { __builtin_amdgcn_s_setprio(1); _Pragma("unroll") for (int m = 0; m < 4; ++m) _Pragma("unroll") for (int n = 0; n < 2; ++n) _Pragma("unroll") for (int k = 0; k < 2; ++k) \
        acc[ai][bj][m][n] = __builtin_amdgcn_mfma_f32_16x16x32_bf16(Bt[n][k], At[m][k], acc[ai][bj][m][n], 0, 0, 0); __builtin_amdgcn_s_setprio(0); } while (0)
#define PG8_WAIT_V(n) asm volatile("s_waitcnt vmcnt(" #n ")" ::: "memory")
#define PG8_WAIT_L(n) asm volatile("s_waitcnt lgkmcnt(" #n ")" ::: "memory")
#define PG8_BAR __builtin_amdgcn_s_barrier()
#define PG8_SCHED __builtin_amdgcn_sched_barrier(0)
#define PG8_AOFFS(u, o00, o01, o10, o11) do { \
        if constexpr (GATHER) { const int* ri_ = g.rowidx + (size_t)(u).pm * BM; \
            const int r00 = ri_[RA[0]], r01 = ri_[RA[1]], r10 = ri_[HALF + RA[0]], r11 = ri_[HALF + RA[1]]; \
            o00 = (unsigned)r00 * (unsigned)(K * 2) + (unsigned)CA2[0]; o01 = (unsigned)r01 * (unsigned)(K * 2) + (unsigned)CA2[1]; \
            o10 = (unsigned)r10 * (unsigned)(K * 2) + (unsigned)CA2[0]; o11 = (unsigned)r11 * (unsigned)(K * 2) + (unsigned)CA2[1]; } \
        else { o00 = (unsigned)(RA[0] * K * 2 + CA2[0]); o01 = (unsigned)(RA[1] * K * 2 + CA2[1]); o10 = o00 + (unsigned)hstep; o11 = o01 + (unsigned)hstep; } } while (0)
    Unit cur, nxt; int ui = 0;
    if (!S.next(0, cur)) return;
    f32x4 acc[2][2][4][2];
#pragma unroll
    for (int a = 0; a < 2; ++a)
#pragma unroll
        for (int b = 0; b < 2; ++b)
#pragma unroll
            for (int m = 0; m < 4; ++m)
#pragma unroll
                for (int n = 0; n < 2; ++n) acc[a][b][m][n] = (f32x4){0.f, 0.f, 0.f, 0.f};
    bf16x8 At[4][2], B0[2][2], B1[2][2];
    const char* cA = GATHER ? (const char*)g.A : (const char*)g.A + (size_t)cur.pm * tstep; const char* cB = (const char*)g.Bt + (size_t)cur.pn * tstep;
    PG8_AOFFS(cur, cv00, cv01, cv10, cv11);
    if constexpr (GATHER) { asm volatile("s_waitcnt vmcnt(0)" ::: "memory"); }
    S.a_ready(cur);
    PG8_STAGE(PG8_SB(0, 0), cB, voffB); PG8_STAGE(PG8_SB(0, 1), cB + hstep, voffB); PG8_STAGEA(PG8_SA(0, 0), cA, cv00, cv01); PG8_STAGEA(PG8_SA(0, 1), cA, cv10, cv11);
    if (wr == 1) PG8_BAR;
    PG8_WAIT_V(2); PG8_BAR;
    PG8_STAGE(PG8_SB(1, 0), cB + kstep, voffB); PG8_STAGEA(PG8_SA(1, 0), cA + kstep, cv00, cv01); PG8_STAGE(PG8_SB(1, 1), cB + hstep + kstep, voffB);
    PG8_WAIT_V(6); PG8_BAR;
    for (;;) {
        const bool has_next = S.next(ui + 1, nxt);
        const char* nA = (has_next && !GATHER) ? (const char*)g.A + (size_t)nxt.pm * tstep : cA; const char* nB = has_next ? (const char*)g.Bt + (size_t)nxt.pn * tstep : cB;
        if constexpr (GATHER) {
            if (has_next) { PG8_AOFFS(nxt, nv00, nv01, nv10, nv11); } else { nv00 = cv00; nv01 = cv01; nv10 = cv10; nv11 = cv11; }
        } else { nv00 = cv00; nv01 = cv01; nv10 = cv10; nv11 = cv11; }
        for (int t = 0; t < nt; t += 2) {
            const bool last = (t == nt - 2);
            const char* a1 = cA + (size_t)(t + 1) * kstep;
            const char* a2 = last ? nA : cA + (size_t)(t + 2) * kstep; const char* b2 = last ? nB : cB + (size_t)(t + 2) * kstep;
            const char* a3 = a2 + kstep; const char* b3 = b2 + kstep;
            unsigned x00 = cv00, x01 = cv01, x10 = cv10, x11 = cv11;
            if constexpr (GATHER) { if (last) { x00 = nv00; x01 = nv01; x10 = nv10; x11 = nv11; } }
            if (last && has_next) S.a_ready(nxt);
            PG8_LDB(B0, 0, 0); PG8_LDB(B1, 0, 1); PG8_SCHED; PG8_LDA(At, 0, 0); PG8_STAGEA(PG8_SA(1, 1), a1, cv10, cv11);
            PG8_WAIT_V(8); PG8_WAIT_L(0); PG8_BAR; PG8_MMA(0, 0, At, B0); PG8_MMA(0, 1, At, B1); PG8_BAR; PG8_SCHED;
            PG8_LDA(At, 0, 1); PG8_STAGE(PG8_SB(0, 0), b2, voffB); PG8_STAGE(PG8_SB(0, 1), b2 + hstep, voffB); PG8_STAGEA(PG8_SA(0, 0), a2, x00, x01);
            PG8_WAIT_V(8); PG8_WAIT_L(0); PG8_BAR; PG8_MMA(1, 0, At, B0); PG8_MMA(1, 1, At, B1); PG8_BAR; PG8_SCHED;
            PG8_LDB(B0, 1, 0); PG8_LDB(B1, 1, 1); PG8_SCHED; PG8_LDA(At, 1, 0); PG8_STAGEA(PG8_SA(0, 1), a2, x10, x11);
            PG8_WAIT_V(8); PG8_WAIT_L(0); PG8_BAR; PG8_MMA(0, 0, At, B0); PG8_MMA(0, 1, At, B1); PG8_BAR; PG8_SCHED;
            PG8_LDA(At, 1, 1); PG8_STAGE(PG8_SB(1, 0), b3, voffB); PG8_STAGE(PG8_SB(1, 1), b3 + hstep, voffB); PG8_STAGEA(PG8_SA(1, 0), a3, x00, x01);
            PG8_WAIT_V(8); PG8_WAIT_L(0); PG8_BAR; PG8_MMA(1, 0, At, B0); PG8_MMA(1, 1, At, B1); PG8_BAR; PG8_SCHED;
        }
        if (wr == 0) PG8_BAR;
        E(acc, cur, wr, wc, fr, fq); S.done(cur);
        if (!has_next) break;
#pragma unroll
        for (int a = 0; a < 2; ++a)
#pragma unroll
            for (int b = 0; b < 2; ++b)
#pragma unroll
                for (int m = 0; m < 4; ++m)
#pragma unroll
                    for (int n = 0; n < 2; ++n) acc[a][b][m][n] = (f32x4){0.f, 0.f, 0.f, 0.f};
        cur = nxt; cA = nA; cB = nB; ++ui; cv00 = nv00; cv01 = nv01; cv10 = nv10; cv11 = nv11;
        if (wr == 1) PG8_BAR;
    }
    PG8_WAIT_V(0);
    PG8_BAR;
#undef PG8_SA
#undef PG8_SB
#undef PG8_STAGE
#undef PG8_STAGEA
#undef PG8_LDA
#undef PG8_LDB
#undef PG8_MMA
#undef PG8_WAIT_V
#undef PG8_WAIT_L
#undef PG8_BAR
#undef PG8_SCHED
#undef PG8_AOFFS
}
}
#define GAS __attribute__((address_space(1)))
#define LAS __attribute__((address_space(3)))
typedef unsigned short bf16;
typedef unsigned v4u __attribute__((ext_vector_type(4)));
typedef float f32x4 __attribute__((ext_vector_type(4)));
typedef short bf16x8 __attribute__((ext_vector_type(8)));
typedef GAS unsigned gu32;
typedef GAS unsigned long long gu64;
#define RLX_AGENT __ATOMIC_RELAXED, __HIP_MEMORY_SCOPE_AGENT
#define LDS_WAIT() asm volatile("s_waitcnt lgkmcnt(0)" ::: "memory")
#define VM_WAIT() asm volatile("s_waitcnt vmcnt(0)" ::: "memory")
__device__ __forceinline__ unsigned long long rt() { return __builtin_amdgcn_s_memrealtime(); }
__device__ __forceinline__ unsigned f2bf(float f) { unsigned u = __builtin_bit_cast(unsigned, f); return (u + 0x7fffu + ((u >> 16) & 1u)) >> 16; }
__device__ __forceinline__ unsigned pk2(float lo, float hi) { return f2bf(lo) | (f2bf(hi) << 16); }

#define XB_TMO      128
#define XB_XCNT(j)  (256  + 64 * (j))
#define XB_XSUB(j)  (1280 + 64 * (j))
#define XB_XGEN(j)  (2304 + 64 * (j))
#define XB_TOP      3328
#define XB_TOPGEN   3392
#define XCD_BAR_WORDS 3456
#define XB_SPIN_CAP (1u << 18)

__device__ __forceinline__ unsigned xb_ld(unsigned* p)              { return __hip_atomic_load(p, __ATOMIC_RELAXED, __HIP_MEMORY_SCOPE_AGENT); }
__device__ __forceinline__ unsigned xb_add(unsigned* p, unsigned v) { return __hip_atomic_fetch_add(p, v, __ATOMIC_RELAXED, __HIP_MEMORY_SCOPE_AGENT); }
__device__ __forceinline__ unsigned xb_xcc_id() { return (unsigned)__builtin_amdgcn_s_getreg((3 << 11) | 20) & 0xFu; }
#define XB_SPIN(cond, bar) do { unsigned _sp = 0; while (cond) { __builtin_amdgcn_s_sleep(1); \
    if ((++_sp & 255u) == 0u) { if (xb_ld(&(bar)[XB_TMO])) break; if (_sp > XB_SPIN_CAP) { atomicAdd(&(bar)[XB_TMO], 1u); break; } } } } while (0)

struct XcdBarrier {
    unsigned* bar; unsigned x;
    volatile LAS unsigned* st;
};

__device__ __forceinline__ XcdBarrier xcd_barrier_post(unsigned* bar, volatile LAS unsigned* st) {
    XcdBarrier b; b.bar = bar; b.x = xb_xcc_id(); b.st = st;
    if (threadIdx.x == 0) (void)xb_add(&bar[XB_XCNT(b.x)], 1u);
    return b;
}
__device__ __forceinline__ void xcd_barrier_complete(unsigned* bar, unsigned x, unsigned& nloc, unsigned& nx) {
    const unsigned G = gridDim.x * gridDim.y * gridDim.z;
    unsigned sum, cnt, mine, sp = 0u;
    for (;;) {
        sum = 0u; cnt = 0u; mine = 0u;
#pragma unroll
        for (unsigned j = 0; j < 16; ++j) { const unsigned c = xb_ld(&bar[XB_XCNT(j)]); sum += c; cnt += (c > 0u) ? 1u : 0u; mine = (j == x) ? c : mine; }
        if (sum == G) break;
        __builtin_amdgcn_s_sleep(1);
        if ((++sp & 255u) == 0u) { if (xb_ld(&bar[XB_TMO])) break; if (sp > XB_SPIN_CAP) { atomicAdd(&bar[XB_TMO], 1u); break; } }
    }
    nloc = mine > 0u ? mine : 1u; nx = cnt > 0u ? cnt : 1u;
}

__device__ __forceinline__ void xcd_barrier(const XcdBarrier& b) {
    asm volatile("s_waitcnt vmcnt(0)" ::: "memory");
    __syncthreads();
    if (threadIdx.x == 0) {
        unsigned* bar = b.bar;
        __builtin_amdgcn_s_waitcnt(0);
        unsigned nloc = b.st[0], nx = b.st[1];
        if (nloc == 0u) { xcd_barrier_complete(bar, b.x, nloc, nx); b.st[0] = nloc; b.st[1] = nx; }
        const unsigned old = xb_add(&bar[XB_XSUB(b.x)], 1u);
        const unsigned gen = old / nloc;
        if (old + 1u == (gen + 1u) * nloc) {
            __builtin_amdgcn_fence(__ATOMIC_RELEASE, "agent");
            asm volatile("s_waitcnt vmcnt(0)" ::: "memory");
            const unsigned og = xb_add(&bar[XB_TOP], 1u);
            const unsigned tg = og / nx;
            if (og + 1u == (tg + 1u) * nx) xb_add(&bar[XB_TOPGEN], 1u);
            else XB_SPIN(xb_ld(&bar[XB_TOPGEN]) == tg, bar);
            __builtin_amdgcn_fence(__ATOMIC_ACQUIRE, "agent");
            xb_add(&bar[XB_XGEN(b.x)], 1u);
            asm volatile("s_waitcnt vmcnt(0)" ::: "memory");
        } else {
            XB_SPIN(xb_ld(&bar[XB_XGEN(b.x)]) == gen, bar);
            __builtin_amdgcn_fence(__ATOMIC_ACQUIRE, "agent");
            asm volatile("s_waitcnt vmcnt(0)" ::: "memory");
        }
    }
    __syncthreads();
}

constexpr int NWAVES = 8, NTHR = NWAVES * 64;
constexpr int BATCH = 8, SEQ = 2048, D = 1024, M = BATCH * SEQ;
constexpr int NIN = 3072, AW = 512, NHEAD = 8, HD = 64, RH = 4, RDK = 64, RDV = 128;
constexpr int DFF = 2816, NE = 8, DFE = 3584;
constexpr int MODW = 6 * D;
constexpr int MAXTILES = 136, MAXSLOT = MAXTILES * 256;
constexpr float EPS = 1e-6f;

constexpr size_t MiB = 1u << 20;
constexpr size_t WS_CTL = 0, CTL_ZERO_BYTES = 1 * MiB;
constexpr size_t WS_MOD = 1 * MiB;
constexpr size_t WS_ROPE = WS_MOD + 512 * 1024;
constexpr size_t WS_TOK = 2 * MiB;
constexpr size_t TOK_E = WS_TOK, TOK_W = TOK_E + 131072, TOK_SLOT = TOK_W + 131072, TOK_DST = TOK_SLOT + 131072, SORTED_TOK = TOK_DST + 131072, SLOT_W = SORTED_TOK + MAXSLOT * 4;
static_assert(SLOT_W + MAXSLOT * 4 <= 3 * MiB, "tok tables");
constexpr size_t WS_MOE13 = 3 * MiB;
constexpr size_t WS_MOE2 = 115 * MiB;
constexpr size_t WS_WIN = 171 * MiB;
constexpr size_t WS_WOUT = 183 * MiB;
constexpr size_t WS_F13 = 187 * MiB;
constexpr size_t WS_F2 = 198 * MiB;
constexpr size_t WS_H = 204 * MiB;
constexpr size_t WS_Y = 171 * MiB;
constexpr size_t WS_ARENA = 240 * MiB;
constexpr size_t WS_Q = WS_ARENA, WS_K = WS_ARENA + 16 * MiB, WS_V = WS_ARENA + 32 * MiB, WS_RQ = WS_ARENA + 48 * MiB, WS_RK = WS_ARENA + 56 * MiB,
                 WS_RV = WS_ARENA + 64 * MiB, WS_RG = WS_ARENA + 80 * MiB, WS_ATTO = WS_ARENA + 96 * MiB, WS_LSE = WS_ARENA + 144 * MiB,
                 WS_KVST = WS_ARENA + 146 * MiB, WS_MIXED = WS_ARENA + 162 * MiB;
constexpr size_t WS_HID = WS_ARENA;
constexpr size_t WS_END = 478 * MiB;
static_assert(WS_Y + (size_t)MAXSLOT * D * 2 <= WS_ARENA && WS_HID + (size_t)MAXSLOT * DFE * 2 <= WS_END && WS_MIXED + 32 * MiB <= WS_END, "ws map");
constexpr int CW_TMO = 0, CW_CODE = 1;
constexpr int CW_CNT = 8192;
constexpr int CW_BAR = 16384;
constexpr int MAX_BAR_REGIONS = 24;
static_assert((CW_BAR + MAX_BAR_REGIONS * XCD_BAR_WORDS) * 4 <= (int)CTL_ZERO_BYTES, "CTL words inside the memset region");

constexpr int RING_OFF = 0, RING_BYTES = 131072;
constexpr int LDSCTL_OFF = RING_BYTES, MISC_OFF = LDSCTL_OFF + 320;
constexpr int LDS_BYTES = 147456;
static_assert(MISC_OFF + 128 <= LDS_BYTES, "LDS map");

__device__ const unsigned char T5_BUCKET[3][132] = {
{0,1,2,3,4,5,6,7,8,9,10,11,12,13,14,15,16,16,16,16,16,16,17,17,17,17,17,17,17,17,18,18,18,18,18,18,18,18,18,18,19,19,19,19,19,19,19,19,19,19,19,19,19,19,20,20,20,20,20,20,20,20,20,20,20,20,20,20,20,20,20,20,20,21,21,21,21,21,21,21,21,21,21,21,21,21,21,21,21,21,21,21,21,21,21,21,21,21,21,22,22,22,22,22,22,22,22,22,22,22,22,22,22,22,22,22,22,22,22,22,22,22,22,22,22,22,22,22,22,0,0,0},
{0,4,8,12,16,16,17,17,18,18,19,19,19,19,20,20,20,20,20,21,21,21,21,21,21,22,22,22,22,22,22,22,22,22,23,23,23,23,23,23,23,23,23,23,23,23,24,24,24,24,24,24,24,24,24,24,24,24,24,24,24,24,25,25,25,25,25,25,25,25,25,25,25,25,25,25,25,25,25,25,25,25,25,26,26,26,26,26,26,26,26,26,26,26,26,26,26,26,26,26,26,26,26,26,26,26,26,26,26,26,26,26,26,27,27,27,27,27,27,27,27,27,27,27,27,27,27,27,27,0,0,0},
{0,16,18,19,20,21,21,22,22,23,23,23,24,24,24,24,25,25,25,25,25,26,26,26,26,26,26,26,26,27,27,27,27,27,27,27,27,27,27,28,28,28,28,28,28,28,28,28,28,28,28,28,29,29,29,29,29,29,29,29,29,29,29,29,29,29,29,29,29,29,30,30,30,30,30,30,30,30,30,30,30,30,30,30,30,30,30,30,30,30,30,30,30,30,30,31,31,31,31,31,31,31,31,31,31,31,31,31,31,31,31,31,31,31,31,31,31,31,31,31,31,31,31,31,31,31,31,31,31,0,0,0}};

using pg8::Unit; using pg8::cvt_pk_bf16; using pg8::u32x4;
typedef unsigned u32x2 __attribute__((ext_vector_type(2)));
__device__ __forceinline__ float wave_sum(float v) {
#pragma unroll
    for (int o = 1; o < 64; o <<= 1) v += __shfl_xor(v, o);
    return v;
}
__device__ __forceinline__ float bf2f(unsigned short h) { return __builtin_bit_cast(float, (unsigned)h << 16); }
__device__ __forceinline__ float bflo(unsigned w) { return __builtin_bit_cast(float, w << 16); }
__device__ __forceinline__ float bfhi(unsigned w) { return __builtin_bit_cast(float, w & 0xffff0000u); }
__device__ __forceinline__ void st8(bf16* p, f32x4 a, f32x4 b) {
    u32x4 w; w.x = cvt_pk_bf16(a[0], a[1]); w.y = cvt_pk_bf16(a[2], a[3]); w.z = cvt_pk_bf16(b[0], b[1]); w.w = cvt_pk_bf16(b[2], b[3]); *(u32x4*)p = w; }
__device__ __forceinline__ float silu_f(float x) { return x * __builtin_amdgcn_rcpf(1.0f + __builtin_amdgcn_exp2f(-1.4426950408889634f * x)); }
__device__ __forceinline__ f32x4 silu4(f32x4 x) { return (f32x4){silu_f(x[0]), silu_f(x[1]), silu_f(x[2]), silu_f(x[3])}; }
__device__ __forceinline__ float ret_lg(int h) { return __builtin_log2f(1.0f - __builtin_amdgcn_exp2f(-5.0f - (float)h)); }

struct EpiInProj {
    static constexpr bool PERM = true, AFTER_DRAIN = false;
    unsigned char* wsb; const float *qg, *kg;
    __device__ __forceinline__ void operator()(const f32x4 (&acc)[2][2][4][2], const Unit& u, int wr, int wc, int fr, int fq) const {
        const int pn = u.pn, row0 = u.pm * pg8::BM + wr * 64 + fr;
        if (pn < 4) {
            const bool isq = pn < 2; const float* gp = isq ? qg : kg; bf16* dst = (bf16*)(wsb + (isq ? WS_Q : WS_K)); const float sc = isq ? 0.125f : 1.0f;
            const int head = 4 * (pn & 1) + wc;
            f32x4 gv[2][2];
#pragma unroll
            for (int bj = 0; bj < 2; ++bj)
#pragma unroll
                for (int n = 0; n < 2; ++n) gv[bj][n] = *(const f32x4*)(gp + 32 * bj + 8 * fq + 4 * n);
#pragma unroll
            for (int ai = 0; ai < 2; ++ai)
#pragma unroll
                for (int m = 0; m < 4; ++m) {
                    float ss = 0.f;
#pragma unroll
                    for (int bj = 0; bj < 2; ++bj)
#pragma unroll
                        for (int n = 0; n < 2; ++n) { const f32x4 x = acc[ai][bj][m][n]; ss += (x[0] * x[0] + x[1] * x[1]) + (x[2] * x[2] + x[3] * x[3]); }
                    ss += __shfl_xor(ss, 16); ss += __shfl_xor(ss, 32);
                    const float r = __builtin_amdgcn_rsqf(ss * (1.0f / 64.0f) + EPS) * sc;
                    bf16* rp = dst + (size_t)(row0 + ai * pg8::HALF + m * 16) * AW + head * 64 + 8 * fq;
#pragma unroll
                    for (int bj = 0; bj < 2; ++bj) st8(rp + 32 * bj, acc[ai][bj][m][0] * r * gv[bj][0], acc[ai][bj][m][1] * r * gv[bj][1]);
                }
        } else if (pn == 6 || pn == 7) {
            const bool isq = pn == 6; bf16* dst = (bf16*)(wsb + (isq ? WS_RQ : WS_RK)); const int head = wc; const float lg = ret_lg(head);
            const float* cosT = (const float*)(wsb + WS_ROPE); const float* sinT = cosT + SEQ * 32;
#pragma unroll
            for (int ai = 0; ai < 2; ++ai)
#pragma unroll
                for (int m = 0; m < 4; ++m) {
                    const int row = row0 + ai * pg8::HALF + m * 16, pos = row & (SEQ - 1); const float p = (float)(pos & 127);
                    const float sc = isq ? 0.125f * __builtin_amdgcn_exp2f(p * lg) : __builtin_amdgcn_exp2f(-p * lg);
                    const float* cp = cosT + pos * 32 + 8 * fq; const float* sp = sinT + pos * 32 + 8 * fq;
                    const f32x4 c0 = *(const f32x4*)cp, c1 = *(const f32x4*)(cp + 4), s0 = *(const f32x4*)sp, s1 = *(const f32x4*)(sp + 4);
                    const f32x4 a0 = acc[ai][0][m][0], a1 = acc[ai][0][m][1], b0 = acc[ai][1][m][0], b1 = acc[ai][1][m][1];
                    bf16* rp = dst + (size_t)row * 256 + head * 64 + 8 * fq;
                    st8(rp, (a0 * c0 - b0 * s0) * sc, (a1 * c1 - b1 * s1) * sc);
                    st8(rp + 32, (a0 * s0 + b0 * c0) * sc, (a1 * s1 + b1 * c1) * sc);
                }
        } else {
            size_t doff; int col0;
            if (pn < 6) { doff = WS_V; col0 = (pn - 4) * 256; } else if (pn < 10) { doff = WS_RV; col0 = (pn - 8) * 256; } else { doff = WS_RG; col0 = (pn - 10) * 256; }
            bf16* dst = (bf16*)(wsb + doff);
            col0 += wc * 32 + 8 * fq;
#pragma unroll
            for (int ai = 0; ai < 2; ++ai)
#pragma unroll
                for (int m = 0; m < 4; ++m) { bf16* rp = dst + (size_t)(row0 + ai * pg8::HALF + m * 16) * 512 + col0;
#pragma unroll
                    for (int bj = 0; bj < 2; ++bj) st8(rp + bj * pg8::HALF, acc[ai][bj][m][0], acc[ai][bj][m][1]); }
        }
    }
};
struct EpiResid {
    static constexpr bool PERM = false, AFTER_DRAIN = false;
    const float* base; float* out; const float* gate;
    __device__ __forceinline__ void operator()(const f32x4 (&acc)[2][2][4][2], const Unit& u, int wr, int wc, int fr, int fq) const {
        const int row0 = u.pm * pg8::BM + wr * 64 + fr, col0 = u.pn * pg8::BM + wc * 32 + 4 * fq, b = u.pm >> 3;
        f32x4 gv[2][2];
#pragma unroll
        for (int bj = 0; bj < 2; ++bj)
#pragma unroll
            for (int n = 0; n < 2; ++n) gv[bj][n] = *(const f32x4*)(gate + (size_t)b * MODW + col0 + bj * pg8::HALF + n * 16);
#pragma unroll
        for (int ai = 0; ai < 2; ++ai)
#pragma unroll
            for (int m = 0; m < 4; ++m) { const size_t off = (size_t)(row0 + ai * pg8::HALF + m * 16) * D + col0;
#pragma unroll
                for (int bj = 0; bj < 2; ++bj)
#pragma unroll
                    for (int n = 0; n < 2; ++n) { const f32x4 xv = *(const f32x4*)(base + off + bj * pg8::HALF + n * 16); *(f32x4*)(out + off + bj * pg8::HALF + n * 16) = xv + gv[bj][n] * acc[ai][bj][m][n]; } }
    }
};
struct EpiSwiglu {
    static constexpr bool PERM = true, AFTER_DRAIN = false;
    bf16* Hd; int ldh, ntn;
    __device__ __forceinline__ void operator()(const f32x4 (&acc)[2][2][4][2], const Unit& u, int wr, int wc, int fr, int fq) const {
        const int pnl = u.pn % ntn, row0 = u.pm * pg8::BM + wr * 64 + fr, col0 = pnl * 128 + wc * 32 + 8 * fq;
#pragma unroll
        for (int ai = 0; ai < 2; ++ai)
#pragma unroll
            for (int m = 0; m < 4; ++m)
                st8(Hd + (size_t)(row0 + ai * pg8::HALF + m * 16) * ldh + col0, silu4(acc[ai][0][m][0]) * acc[ai][1][m][0], silu4(acc[ai][0][m][1]) * acc[ai][1][m][1]);
    }
};
struct EpiMoe2 {
    static constexpr bool PERM = true, AFTER_DRAIN = false;
    bf16* Y; const float* slot_w;
    __device__ __forceinline__ void operator()(const f32x4 (&acc)[2][2][4][2], const Unit& u, int wr, int wc, int fr, int fq) const {
        const int pnl = u.pn & 3, row0 = u.pm * pg8::BM + wr * 64 + fr, col0 = pnl * 256 + wc * 32 + 8 * fq;
#pragma unroll
        for (int ai = 0; ai < 2; ++ai)
#pragma unroll
            for (int m = 0; m < 4; ++m) { const int row = row0 + ai * pg8::HALF + m * 16; const float w = slot_w[row];
#pragma unroll
                for (int bj = 0; bj < 2; ++bj) st8(Y + (size_t)row * D + col0 + bj * pg8::HALF, acc[ai][bj][m][0] * w, acc[ai][bj][m][1] * w); }
    }
};
struct MoeOrder {
    int t0, t1, t2, t3, t4, t5, t6, t7, t8; int ntn, G, c;
    __device__ __forceinline__ void init(const unsigned* cnt, int ntn_, int G_, int c_) {
        ntn = ntn_; G = G_; c = c_;
        t0 = 0; t1 = t0 + (int)((cnt[0] + 255u) >> 8); t2 = t1 + (int)((cnt[64] + 255u) >> 8); t3 = t2 + (int)((cnt[128] + 255u) >> 8); t4 = t3 + (int)((cnt[192] + 255u) >> 8);
        t5 = t4 + (int)((cnt[256] + 255u) >> 8); t6 = t5 + (int)((cnt[320] + 255u) >> 8); t7 = t6 + (int)((cnt[384] + 255u) >> 8); t8 = t7 + (int)((cnt[448] + 255u) >> 8);
    }
    __device__ __forceinline__ bool next(int i, Unit& u) const {
        const int L = i * G + c; if (L >= t8 * ntn) return false;
        int e = 0, lo = 0, hi = t1;
        if (L >= t1 * ntn) { e = 1; lo = t1; hi = t2; }
        if (L >= t2 * ntn) { e = 2; lo = t2; hi = t3; }
        if (L >= t3 * ntn) { e = 3; lo = t3; hi = t4; }
        if (L >= t4 * ntn) { e = 4; lo = t4; hi = t5; }
        if (L >= t5 * ntn) { e = 5; lo = t5; hi = t6; }
        if (L >= t6 * ntn) { e = 6; lo = t6; hi = t7; }
        if (L >= t7 * ntn) { e = 7; lo = t7; hi = t8; }
        const int te = hi - lo, loc = L - lo * ntn, j = loc / te, r = loc - j * te;
        u.pm = lo + r; u.pn = e * ntn + j; return true;
    }
    __device__ __forceinline__ void a_ready(const Unit&) const {}
    __device__ __forceinline__ void done(const Unit&) const {}
};

struct Frame { LAS unsigned char* lds; int tid, lane, wave, G, bid; };
__device__ __forceinline__ Frame phase_frame(const Frame& F) { Frame f = F; asm volatile("" : "+v"(f.tid)); f.lane = f.tid & 63; return f; }

__device__ __forceinline__ void transpose_item(const float* W, int K, int N, bf16* WT, int drow0, LAS float* scr, int k0, int n0, int lane) {
#pragma unroll 8
    for (int i = 0; i < 32; ++i) { const int kk = 2 * i + (lane >> 5); scr[kk * 33 + (lane & 31)] = W[(size_t)(k0 + kk) * N + n0 + (lane & 31)]; }
    LDS_WAIT(); asm volatile("" ::: "memory");
    const int c = lane & 7;
#pragma unroll
    for (int j = 0; j < 4; ++j) { const int n = (lane >> 3) + 8 * j; const LAS float* s = scr + (8 * c) * 33 + n;
        v4u o; o.x = pk2(s[0 * 33], s[1 * 33]); o.y = pk2(s[2 * 33], s[3 * 33]); o.z = pk2(s[4 * 33], s[5 * 33]); o.w = pk2(s[6 * 33], s[7 * 33]);
        *(GAS v4u*)(WT + (size_t)(drow0 + n) * K + k0 + 8 * c) = o; }
    LDS_WAIT(); asm volatile("" ::: "memory");
}
__device__ __forceinline__ int inproj_dst_row(int n0) {
    const int pn = n0 >> 8, c = n0 & 255;
    const bool perm = (pn < 4) || pn == 6 || pn == 7;
    if (!perm) return n0;
    return (pn << 8) + 128 * ((c >> 5) & 1) + 32 * (c >> 6);
}
__device__ __forceinline__ int swiglu_dst_row(int n0, int second) { return 256 * (n0 >> 7) + (n0 & 127) + 128 * second; }

struct Ptrs {
    const float *x, *c, *bias_tab, *norm_mix, *norm_ffn, *w_mod, *b_mod, *w_in, *q_gain, *k_gain, *ret_gain, *w_out, *ffn_w1, *ffn_w3, *ffn_w2, *router, *moe_w1, *moe_w3, *moe_w2;
    float* out; unsigned char* ws;
};

__device__ __forceinline__ void p0_prologue(const Frame& F, const Ptrs& P) {
    unsigned char* ws = P.ws;
    {
        LAS float* cact = (LAS float*)(F.lds);
        LAS float* red = (LAS float*)(F.lds + 32768);
        for (int i = F.tid; i < BATCH * D; i += NTHR) { const int b = i >> 10, k = i & 1023; cact[k * 8 + b] = silu_f(P.c[i]); }
        __syncthreads();
        float* MOD = (float*)(ws + WS_MOD);
        for (int it = F.bid; it < 2 * (MODW / 64); it += F.G) {
            const int l = it / (MODW / 64), cc = it % (MODW / 64), col = cc * 64 + F.lane;
            const float* Wp = P.w_mod + (size_t)l * D * MODW + col;
            float a[8];
#pragma unroll
            for (int b = 0; b < 8; ++b) a[b] = 0.f;
            const int kb = F.wave * 128;
#pragma unroll 8
            for (int k = 0; k < 128; ++k) { const float w = Wp[(size_t)(kb + k) * MODW]; const f32x4 c0 = *(const LAS f32x4*)(cact + (kb + k) * 8), c1 = *(const LAS f32x4*)(cact + (kb + k) * 8 + 4);
                a[0] += c0[0] * w; a[1] += c0[1] * w; a[2] += c0[2] * w; a[3] += c0[3] * w; a[4] += c1[0] * w; a[5] += c1[1] * w; a[6] += c1[2] * w; a[7] += c1[3] * w; }
#pragma unroll
            for (int b = 0; b < 8; ++b) red[(F.wave * 8 + b) * 64 + F.lane] = a[b];
            __syncthreads();
            { const int b = F.wave, ln = F.lane; float s = 0.f;
#pragma unroll
              for (int w = 0; w < 8; ++w) s += red[(w * 8 + b) * 64 + ln];
              MOD[(size_t)l * BATCH * MODW + (size_t)b * MODW + cc * 64 + ln] = s + P.b_mod[l * MODW + cc * 64 + ln]; }
            __syncthreads();
        }
    }
    {
        float* cosT = (float*)(ws + WS_ROPE); float* sinT = cosT + SEQ * 32;
        for (int i = F.bid * NTHR + F.tid; i < SEQ * 32; i += F.G * NTHR) { const int pos = i >> 5, j = i & 31;
            const float inv = powf(10000.0f, -(float)j / 32.0f), ang = (float)pos * inv; float s, c; sincosf(ang, &s, &c); cosT[i] = c; sinT[i] = s; }
    }
    {
        LAS float* scr = (LAS float*)(F.lds + F.wave * 16384);
        const int gw = F.bid * NWAVES + F.wave, NGW = F.G * NWAVES;
        constexpr int I_IN = 16 * 96, I_OUT = 16 * 32, I_F13 = 16 * 88, I_F2 = 44 * 32, I_M13 = 16 * 112, I_M2 = 56 * 32;
        constexpr int B0 = 0, B1 = B0 + 2 * I_IN, B2 = B1 + 2 * I_OUT, B3 = B2 + 2 * I_F13, B4 = B3 + I_F2, B5 = B4 + 16 * I_M13, NITEMS = B5 + 8 * I_M2;
        __syncthreads();
        for (int it = gw; it < NITEMS; it += NGW) {
            if (it < B1) { const int l = it / I_IN, r = it % I_IN, kb = r / 96, nb = r % 96;
                transpose_item(P.w_in + (size_t)l * D * NIN, D, NIN, (bf16*)(ws + WS_WIN) + (size_t)l * NIN * D, inproj_dst_row(32 * nb), scr, 64 * kb, 32 * nb, F.lane); }
            else if (it < B2) { const int q = it - B1, l = q / I_OUT, r = q % I_OUT, kb = r / 32, nb = r % 32;
                transpose_item(P.w_out + (size_t)l * D * D, D, D, (bf16*)(ws + WS_WOUT) + (size_t)l * D * D, 32 * nb, scr, 64 * kb, 32 * nb, F.lane); }
            else if (it < B3) { const int q = it - B2, second = q / I_F13, r = q % I_F13, kb = r / 88, nb = r % 88;
                transpose_item(second ? P.ffn_w3 : P.ffn_w1, D, DFF, (bf16*)(ws + WS_F13), swiglu_dst_row(32 * nb, second), scr, 64 * kb, 32 * nb, F.lane); }
            else if (it < B4) { const int r = it - B3, kb = r / 32, nb = r % 32;
                transpose_item(P.ffn_w2, DFF, D, (bf16*)(ws + WS_F2), 32 * nb, scr, 64 * kb, 32 * nb, F.lane); }
            else if (it < B5) { const int q = it - B4, me = q / I_M13, second = me >> 3, e = me & 7, r = q % I_M13, kb = r / 112, nb = r % 112;
                transpose_item((second ? P.moe_w3 : P.moe_w1) + (size_t)e * D * DFE, D, DFE, (bf16*)(ws + WS_MOE13) + (size_t)e * 2 * DFE * D, swiglu_dst_row(32 * nb, second), scr, 64 * kb, 32 * nb, F.lane); }
            else { const int q = it - B5, e = q / I_M2, r = q % I_M2, kb = r / 32, nb = r % 32;
                transpose_item(P.moe_w2 + (size_t)e * DFE * D, DFE, D, (bf16*)(ws + WS_MOE2) + (size_t)e * D * DFE, 32 * nb, scr, 64 * kb, 32 * nb, F.lane); }
        }
    }
}

__device__ __forceinline__ void norm_row(const float* xrow, const float* gain, const float* scp, const float* shp, bf16* orow, int lane, f32x4 (&hv)[4]) {
    const GAS f32x4* xr = (const GAS f32x4*)xrow + lane;
    f32x4 v[4]; float s = 0.f;
#pragma unroll
    for (int j = 0; j < 4; ++j) { v[j] = xr[64 * j]; s += (v[j].x * v[j].x + v[j].y * v[j].y) + (v[j].z * v[j].z + v[j].w * v[j].w); }
    const float rstd = 1.0f / sqrtf(wave_sum(s) * (1.0f / D) + EPS);
    GAS u32x2* o8 = (GAS u32x2*)orow + lane;
#pragma unroll
    for (int j = 0; j < 4; ++j) { const f32x4 g = *((const GAS f32x4*)gain + lane + 64 * j), sc = *((const GAS f32x4*)scp + lane + 64 * j), sh = *((const GAS f32x4*)shp + lane + 64 * j);
        const f32x4 o = (v[j] * rstd) * g * (sc + 1.0f) + sh; hv[j] = o;
        u32x2 w; w.x = cvt_pk_bf16(o[0], o[1]); w.y = cvt_pk_bf16(o[2], o[3]); o8[64 * j] = w; }
}
__device__ __forceinline__ void norm_phase(const Frame& F, const float* xin, const float* gain, const float* modl, int ch_shift, int ch_scale, bf16* H) {
    const int gw = F.bid * NWAVES + F.wave, NGW = F.G * NWAVES;
    for (int m = gw; m < M; m += NGW) { const int b = m >> 11; f32x4 hv[4];
        norm_row(xin + (size_t)m * D, gain, modl + (size_t)b * MODW + ch_scale * D, modl + (size_t)b * MODW + ch_shift * D, H + (size_t)m * D, F.lane, hv); }
}
__device__ __forceinline__ void norm_router_phase(const Frame& F, const float* xin, const float* gain, const float* modl, int ch_shift, int ch_scale, bf16* H,
                                                  const float* router, int* tok_e, float* tok_w, int* tok_slot, unsigned* cnt) {
    LAS float* RT = (LAS float*)(F.lds);
    LAS int* lcnt = (LAS int*)(F.lds + 32768);
    LAS int* basee = (LAS int*)(F.lds + 32768 + 64);
    LAS int* rinfo = (LAS int*)(F.lds + 32768 + 128);
    for (int i = F.tid; i < D * NE; i += NTHR) { const int k = i >> 3, e = i & 7; RT[e * D + k] = router[i]; }
    __syncthreads();
    for (int rb = F.bid; rb < M / 64; rb += F.G) {
        if (F.tid < 8) lcnt[F.tid] = 0;
        __syncthreads();
        for (int rr = 0; rr < 8; ++rr) {
            const int lr = F.wave * 8 + rr, m = rb * 64 + lr, b = m >> 11; f32x4 hv[4];
            norm_row(xin + (size_t)m * D, gain, modl + (size_t)b * MODW + ch_scale * D, modl + (size_t)b * MODW + ch_shift * D, H + (size_t)m * D, F.lane, hv);
            float lg[8];
#pragma unroll
            for (int e = 0; e < 8; ++e) { float a = 0.f;
#pragma unroll
                for (int j = 0; j < 4; ++j) { const f32x4 r = *((const LAS f32x4*)(RT + e * D) + F.lane + 64 * j); a += (hv[j][0] * r[0] + hv[j][1] * r[1]) + (hv[j][2] * r[2] + hv[j][3] * r[3]); }
                lg[e] = wave_sum(a); }
            int e1 = 0; float v1 = lg[0];
#pragma unroll
            for (int e = 1; e < 8; ++e) if (lg[e] > v1) { v1 = lg[e]; e1 = e; }
            int e2 = -1; float v2 = -3.0e38f;
#pragma unroll
            for (int e = 0; e < 8; ++e) if (e != e1 && lg[e] > v2) { v2 = lg[e]; e2 = e; }
            if (F.lane == 0) {
                const float w1 = 1.0f / (1.0f + expf(v2 - v1));
                const int l1 = atomicAdd((int*)&lcnt[e1], 1), l2 = atomicAdd((int*)&lcnt[e2], 1);
                rinfo[lr * 4 + 0] = e1; rinfo[lr * 4 + 1] = l1; rinfo[lr * 4 + 2] = e2; rinfo[lr * 4 + 3] = l2;
                tok_e[2 * m] = e1; tok_e[2 * m + 1] = e2; tok_w[2 * m] = w1; tok_w[2 * m + 1] = 1.0f - w1;
            }
        }
        __syncthreads();
        if (F.tid < 8) basee[F.tid] = (int)__hip_atomic_fetch_add(cnt + 64 * F.tid, (unsigned)lcnt[F.tid], __ATOMIC_RELAXED, __HIP_MEMORY_SCOPE_AGENT);
        __syncthreads();
        if (F.tid < 64) { const int m = rb * 64 + F.tid; const int e1 = rinfo[F.tid * 4], l1 = rinfo[F.tid * 4 + 1], e2 = rinfo[F.tid * 4 + 2], l2 = rinfo[F.tid * 4 + 3];
            tok_slot[2 * m] = basee[e1] + l1; tok_slot[2 * m + 1] = basee[e2] + l2; }
        __syncthreads();
    }
}
__device__ __forceinline__ void map_phase(const Frame& F, const unsigned* cnt, const int* tok_e, const float* tok_w, const int* tok_slot, int* tok_dst, int* sorted_tok, float* slot_w) {
    int c[8], off[9]; off[0] = 0;
#pragma unroll
    for (int e = 0; e < 8; ++e) { c[e] = (int)cnt[64 * e]; off[e + 1] = off[e] + ((c[e] + 255) & ~255); }
    const int gt = F.bid * NTHR + F.tid, NT = F.G * NTHR;
    for (int i = gt; i < 2 * M; i += NT) { const int e = tok_e[i]; int o = 0;
#pragma unroll
        for (int k = 0; k < 8; ++k) o = (e == k) ? off[k] : o;
        const int dst = o + tok_slot[i]; tok_dst[i] = dst; sorted_tok[dst] = i >> 1; slot_w[dst] = tok_w[i]; }
    for (int i = gt; i < 8 * 256; i += NT) { const int e = i >> 8, r = i & 255; int o = 0, ce = 0, oe = 0;
#pragma unroll
        for (int k = 0; k < 8; ++k) { o = (e == k) ? off[k] : o; ce = (e == k) ? c[k] : ce; oe = (e == k) ? off[k + 1] : oe; }
        const int p = o + ce + r; if (p < oe) { sorted_tok[p] = 0; slot_w[p] = 0.f; } }
}
__device__ __forceinline__ void combine_phase(const Frame& F, float* x, const float* gate, const bf16* Y, const int* tok_dst) {
    const int gw = F.bid * NWAVES + F.wave, NGW = F.G * NWAVES;
    for (int m = gw; m < M; m += NGW) { const int b = m >> 11; const int d0 = tok_dst[2 * m], d1 = tok_dst[2 * m + 1];
        GAS f32x4* xr = (GAS f32x4*)(x + (size_t)m * D) + F.lane; const GAS u32x2* y0 = (const GAS u32x2*)(Y + (size_t)d0 * D) + F.lane; const GAS u32x2* y1 = (const GAS u32x2*)(Y + (size_t)d1 * D) + F.lane;
        const GAS f32x4* gp = (const GAS f32x4*)(gate + (size_t)b * MODW) + F.lane;
#pragma unroll
        for (int j = 0; j < 4; ++j) { const f32x4 xv = xr[64 * j], g = gp[64 * j]; const u32x2 a = y0[64 * j], bq = y1[64 * j];
            const f32x4 ys = (f32x4){bflo(a.x) + bflo(bq.x), bfhi(a.x) + bfhi(bq.x), bflo(a.y) + bflo(bq.y), bfhi(a.y) + bfhi(bq.y)};
            xr[64 * j] = xv + g * ys; }
    }
}


constexpr int MIXBUF = 65536, BROW_OFF = 132096;
static_assert(BROW_OFF >= MISC_OFF + 128 && BROW_OFF + 2 * 132 * 4 <= LDS_BYTES, "bias rows");
typedef short v4i16_t __attribute__((ext_vector_type(4)));
#define GLDS16(gptr, ldsptr) __builtin_amdgcn_global_load_lds((const unsigned*)(gptr), (LAS unsigned*)(ldsptr), 16, 0, 0)
__device__ __forceinline__ v4i16_t tr_read(const LAS unsigned char* p) { return __builtin_amdgcn_ds_read_tr16_b64_v4i16((LAS v4i16_t*)p); }
__device__ __forceinline__ bf16x8 cat8(v4i16_t a, v4i16_t b) { return (bf16x8){a[0], a[1], a[2], a[3], b[0], b[1], b[2], b[3]}; }
__device__ __forceinline__ bf16x8 pack8(f32x4 a, f32x4 b) { u32x4 w; w.x = cvt_pk_bf16(a[0], a[1]); w.y = cvt_pk_bf16(a[2], a[3]); w.z = cvt_pk_bf16(b[0], b[1]); w.w = cvt_pk_bf16(b[2], b[3]); return __builtin_bit_cast(bf16x8, w); }
__device__ __forceinline__ int img128(int r, int c) { return r * 128 + ((c ^ (r & 7)) << 4); }
__device__ __forceinline__ int img256(int r, int c) { return r * 256 + ((c ^ ((r & 7) << 1)) << 4); }

struct AttnUnit { int p, d, b, h, r, n; };
__device__ __forceinline__ AttnUnit attn_unit(int u) {
    AttnUnit a; a.p = u >> 10; const int v = u & 1023, j = v & 15; a.b = v >> 7; a.h = (v >> 4) & 7;
    a.d = a.p == 0 ? 1 : (a.p == 1 ? 4 : 16);
    if (a.p == 0) { a.r = 0; a.n = j; } else if (a.p == 1) { a.r = j >> 2; a.n = j & 3; } else { a.r = j; a.n = 0; }
    return a;
}
__device__ __forceinline__ void attn_prefetch(const Frame& F, const AttnUnit& a, const bf16* Kg, const bf16* Vg, const float* bias_tab, LAS unsigned char* buf, LAS float* brow) {
    const int c = (F.lane & 7) ^ (F.lane >> 3);
#pragma unroll
    for (int it = 0; it < 4; ++it) {
        const int ii = F.wave + 8 * it;
        if (a.n > 0 || ii >= 16) {
            const int j = 8 * ii + (F.lane >> 3), t = (128 * (a.n - 1) + j) * a.d + a.r;
            const size_t off = ((size_t)(a.b * SEQ + t) * AW + a.h * HD + c * 8) * 2;
            GLDS16((const char*)Kg + off, buf + ii * 1024);
            GLDS16((const char*)Vg + off, buf + 32768 + ii * 1024);
        }
    }
    if (F.tid <= 128) brow[F.tid] = bias_tab[(int)T5_BUCKET[a.p][F.tid] * NHEAD + a.h];
}
__device__ __forceinline__ void attn_compute(const Frame& F, const AttnUnit& a, const LAS unsigned char* buf, const LAS float* brow, bf16x8 qf0, bf16x8 qf1, bf16* Orow, float* lsep) {
    const int w = F.wave, qi = F.lane & 15, g = F.lane >> 4;
    const int jlo = a.n ? 2 * (w >> 1) : 8, cnt = a.n ? 10 : 2 * ((w + 2) >> 1);
    const LAS unsigned char* kb = buf; const LAS unsigned char* vb = buf + 32768;
    f32x4 s[10];
#pragma unroll
    for (int tt = 0; tt < 10; ++tt) {
        s[tt] = (f32x4){0.f, 0.f, 0.f, 0.f};
        if (tt < cnt) { const int key = 16 * (jlo + tt) + qi;
            const bf16x8 a0 = *(const LAS bf16x8*)(kb + img128(key, g)), a1 = *(const LAS bf16x8*)(kb + img128(key, g + 4));
            f32x4 acc = __builtin_amdgcn_mfma_f32_16x16x32_bf16(a0, qf0, (f32x4){0.f, 0.f, 0.f, 0.f}, 0, 0, 0);
            s[tt] = __builtin_amdgcn_mfma_f32_16x16x32_bf16(a1, qf1, acc, 0, 0, 0); }
    }
    const int i = 16 * w + qi; float mx = -1.0e30f;
#pragma unroll
    for (int tt = 0; tt < 10; ++tt) if (tt < cnt) {
#pragma unroll
        for (int rg = 0; rg < 4; ++rg) { const int j = 16 * (jlo + tt) + 4 * g + rg, rel = i - j + 128; const bool ok = rel >= 0 && rel <= 128;
            const float v = ok ? s[tt][rg] + brow[ok ? rel : 0] : -1.0e30f; s[tt][rg] = v; mx = fmaxf(mx, v); } }
    mx = fmaxf(mx, __shfl_xor(mx, 16)); mx = fmaxf(mx, __shfl_xor(mx, 32));
    float sum = 0.f;
#pragma unroll
    for (int tt = 0; tt < 10; ++tt) if (tt < cnt) {
#pragma unroll
        for (int rg = 0; rg < 4; ++rg) { const float pz = __builtin_amdgcn_exp2f((s[tt][rg] - mx) * 1.4426950408889634f); s[tt][rg] = pz; sum += pz; } }
    sum += __shfl_xor(sum, 16); sum += __shfl_xor(sum, 32);
    f32x4 o[4];
#pragma unroll
    for (int dt = 0; dt < 4; ++dt) o[dt] = (f32x4){0.f, 0.f, 0.f, 0.f};
#pragma unroll
    for (int cc = 0; cc < 5; ++cc) if (2 * cc < cnt) {
        const bf16x8 pf = pack8(s[2 * cc], s[2 * cc + 1]);
        const int row = 16 * (jlo + 2 * cc) + 4 * g + (qi >> 2);
#pragma unroll
        for (int dt = 0; dt < 4; ++dt) { const int cch = 2 * dt + ((qi >> 1) & 1), sub = (qi & 1) * 8;
            const v4i16_t v0 = tr_read(vb + img128(row, cch) + sub), v1 = tr_read(vb + img128(row + 16, cch) + sub);
            o[dt] = __builtin_amdgcn_mfma_f32_16x16x32_bf16(cat8(v0, v1), pf, o[dt], 0, 0, 0); }
    }
    const float inv = 1.0f / sum;
#pragma unroll
    for (int dt = 0; dt < 4; ++dt) { u32x2 wv; wv.x = cvt_pk_bf16(o[dt][0] * inv, o[dt][1] * inv); wv.y = cvt_pk_bf16(o[dt][2] * inv, o[dt][3] * inv); *(u32x2*)(Orow + 16 * dt + 4 * g) = wv; }
    if (g == 0) *lsep = mx + __logf(sum);
}
__device__ __forceinline__ void attn_phase(const Frame& F, unsigned char* ws, const float* bias_tab) {
    const bf16* Qg = (const bf16*)(ws + WS_Q); const bf16* Kg = (const bf16*)(ws + WS_K); const bf16* Vg = (const bf16*)(ws + WS_V);
    const int NU = 3 * 1024, nr = (NU + F.G - 1) / F.G;
    LAS float* brow = (LAS float*)(F.lds + BROW_OFF);
    int u = F.bid; AttnUnit cur = attn_unit(u < NU ? u : 0); bool have = u < NU;
    if (have) attn_prefetch(F, cur, Kg, Vg, bias_tab, F.lds, brow);
    for (int k = 0; k < nr; ++k) {
        const int un = (k + 1) * F.G + (int)((unsigned)(F.bid + 37 * (k + 1)) % (unsigned)F.G); const bool hn = (k + 1 < nr) && un < NU; const AttnUnit nxt = attn_unit(hn ? un : 0);
        bf16x8 qf0 = (bf16x8){0, 0, 0, 0, 0, 0, 0, 0}, qf1 = qf0; size_t qrow = 0;
        if (have) { const int qi = F.lane & 15, g = F.lane >> 4; qrow = (size_t)(cur.b * SEQ + (128 * cur.n + 16 * F.wave + qi) * cur.d + cur.r);
            const bf16* qp = Qg + qrow * AW + cur.h * HD + 8 * g; qf0 = *(const bf16x8*)qp; qf1 = *(const bf16x8*)(qp + 32); }
        asm volatile("s_waitcnt vmcnt(0) lgkmcnt(0)" ::: "memory"); __syncthreads();
        if (hn) attn_prefetch(F, nxt, Kg, Vg, bias_tab, F.lds + ((k + 1) & 1) * MIXBUF, brow + ((k + 1) & 1) * 132);
        if (have) attn_compute(F, cur, F.lds + (k & 1) * MIXBUF, brow + (k & 1) * 132, qf0, qf1,
                               (bf16*)(ws + WS_ATTO) + (size_t)cur.p * M * AW + qrow * AW + cur.h * HD, (float*)(ws + WS_LSE) + (size_t)cur.p * M * NHEAD + qrow * NHEAD + cur.h);
        cur = nxt; have = hn;
    }
    asm volatile("s_waitcnt vmcnt(0) lgkmcnt(0)" ::: "memory"); __syncthreads();
}

__device__ __forceinline__ void ret_prefetch(const Frame& F, int unit, const bf16* RKg, const bf16* RVg, LAS unsigned char* buf) {
    const int b = unit >> 6, h = (unit >> 4) & 3, i = unit & 15; const size_t row0 = (size_t)b * SEQ + 128 * i;
    { const int c = (F.lane & 7) ^ (F.lane >> 3);
#pragma unroll
      for (int it = 0; it < 2; ++it) { const int ii = F.wave + 8 * it, pos = 8 * ii + (F.lane >> 3);
          GLDS16((const char*)RKg + ((row0 + pos) * 256 + h * RDK + c * 8) * 2, buf + ii * 1024); } }
#pragma unroll
    for (int it = 0; it < 4; ++it) { const int ii = F.wave + 8 * it, pos = 4 * ii + (F.lane >> 4), c = (F.lane & 15) ^ ((pos & 7) << 1);
        GLDS16((const char*)RVg + ((row0 + pos) * 512 + h * RDV + c * 8) * 2, buf + 16384 + ii * 1024); }
}
__device__ __forceinline__ void ret_kv_compute(const Frame& F, int unit, const LAS unsigned char* buf, float* KVT) {
    const int w = F.wave, qi = F.lane & 15, g = F.lane >> 4;
    const LAS unsigned char* kb = buf; const LAS unsigned char* vb = buf + 16384;
    f32x4 acc[4];
#pragma unroll
    for (int a = 0; a < 4; ++a) acc[a] = (f32x4){0.f, 0.f, 0.f, 0.f};
    const int sub = (qi & 1) * 8;
#pragma unroll
    for (int ch = 0; ch < 4; ++ch) { const int row = 32 * ch + 4 * g + (qi >> 2);
        const int cv = 2 * w + ((qi >> 1) & 1);
        const bf16x8 bfr = cat8(tr_read(vb + img256(row, cv) + sub), tr_read(vb + img256(row + 16, cv) + sub));
#pragma unroll
        for (int a = 0; a < 4; ++a) { const int ck = 2 * a + ((qi >> 1) & 1);
            const bf16x8 afr = cat8(tr_read(kb + img128(row, ck) + sub), tr_read(kb + img128(row + 16, ck) + sub));
            acc[a] = __builtin_amdgcn_mfma_f32_16x16x32_bf16(afr, bfr, acc[a], 0, 0, 0); } }
    float* dst = KVT + ((size_t)unit * RDV + 16 * w + qi) * RDK + 4 * g;
#pragma unroll
    for (int a = 0; a < 4; ++a) *(f32x4*)(dst + 16 * a) = acc[a];
}
__device__ __forceinline__ void ret_kv_phase(const Frame& F, unsigned char* ws) {
    const bf16* RKg = (const bf16*)(ws + WS_RK); const bf16* RVg = (const bf16*)(ws + WS_RV); float* KVT = (float*)(ws + WS_KVST);
    const int NU = BATCH * RH * 16, nr = (NU + F.G - 1) / F.G;
    int u = F.bid; bool have = u < NU;
    if (have) ret_prefetch(F, u, RKg, RVg, F.lds);
    for (int k = 0; k < nr; ++k) {
        const int un = (k + 1) * F.G + F.bid; const bool hn = (k + 1 < nr) && un < NU;
        asm volatile("s_waitcnt vmcnt(0) lgkmcnt(0)" ::: "memory"); __syncthreads();
        if (hn) ret_prefetch(F, un, RKg, RVg, F.lds + ((k + 1) & 1) * MIXBUF);
        if (have) ret_kv_compute(F, u, F.lds + (k & 1) * MIXBUF, KVT);
        u = un; have = hn;
    }
    asm volatile("s_waitcnt vmcnt(0) lgkmcnt(0)" ::: "memory"); __syncthreads();
}
__device__ __forceinline__ void ret_out_compute(const Frame& F, int unit, const LAS unsigned char* buf, bf16x8 qf0, bf16x8 qf1, const bf16* RGg, const float* ret_gain, bf16* MIX) {
    const int w = F.wave, qi = F.lane & 15, g = F.lane >> 4;
    const int b = unit >> 6, h = (unit >> 4) & 3, i = unit & 15; const size_t row = (size_t)b * SEQ + 128 * i + 16 * w + qi;
    const LAS unsigned char* kb = buf; const LAS unsigned char* vb = buf + 16384; const LAS unsigned char* sb = buf + 49152;
    const int nch = (w >> 1) + 1;
    f32x4 s[8];
#pragma unroll
    for (int tt = 0; tt < 8; ++tt) {
        s[tt] = (f32x4){0.f, 0.f, 0.f, 0.f};
        if (tt < 2 * nch) { const int key = 16 * tt + qi;
            const bf16x8 a0 = *(const LAS bf16x8*)(kb + img128(key, g)), a1 = *(const LAS bf16x8*)(kb + img128(key, g + 4));
            f32x4 acc = __builtin_amdgcn_mfma_f32_16x16x32_bf16(a0, qf0, (f32x4){0.f, 0.f, 0.f, 0.f}, 0, 0, 0);
            acc = __builtin_amdgcn_mfma_f32_16x16x32_bf16(a1, qf1, acc, 0, 0, 0);
#pragma unroll
            for (int rg = 0; rg < 4; ++rg) acc[rg] = (16 * tt + 4 * g + rg <= 16 * w + qi) ? acc[rg] : 0.f;
            s[tt] = acc; }
    }
    f32x4 o[8];
#pragma unroll
    for (int dt = 0; dt < 8; ++dt) o[dt] = (f32x4){0.f, 0.f, 0.f, 0.f};
    const int sub = (qi & 1) * 8;
#pragma unroll
    for (int cc = 0; cc < 4; ++cc) if (cc < nch) {
        const bf16x8 pf = pack8(s[2 * cc], s[2 * cc + 1]); const int r0 = 32 * cc + 4 * g + (qi >> 2);
#pragma unroll
        for (int dt = 0; dt < 8; ++dt) { const int cv = 2 * dt + ((qi >> 1) & 1);
            o[dt] = __builtin_amdgcn_mfma_f32_16x16x32_bf16(cat8(tr_read(vb + img256(r0, cv) + sub), tr_read(vb + img256(r0 + 16, cv) + sub)), pf, o[dt], 0, 0, 0); }
    }
    if (i > 0) {
#pragma unroll
        for (int dt = 0; dt < 8; ++dt) { const int dv = 16 * dt + qi;
            const bf16x8 s0 = *(const LAS bf16x8*)(sb + img128(dv, g)), s1 = *(const LAS bf16x8*)(sb + img128(dv, g + 4));
            o[dt] = __builtin_amdgcn_mfma_f32_16x16x32_bf16(s0, qf0, o[dt], 0, 0, 0); o[dt] = __builtin_amdgcn_mfma_f32_16x16x32_bf16(s1, qf1, o[dt], 0, 0, 0); }
    }
    float sm = 0.f;
#pragma unroll
    for (int dt = 0; dt < 8; ++dt) sm += (o[dt][0] + o[dt][1]) + (o[dt][2] + o[dt][3]);
    sm += __shfl_xor(sm, 16); sm += __shfl_xor(sm, 32);
    const float mu = sm * (1.0f / RDV); float sq = 0.f;
#pragma unroll
    for (int dt = 0; dt < 8; ++dt) { o[dt] = o[dt] - mu; sq += (o[dt][0] * o[dt][0] + o[dt][1] * o[dt][1]) + (o[dt][2] * o[dt][2] + o[dt][3] * o[dt][3]); }
    sq += __shfl_xor(sq, 16); sq += __shfl_xor(sq, 32);
    const float rstd = 1.0f / sqrtf(sq * (1.0f / RDV) + EPS);
#pragma unroll
    for (int dt = 0; dt < 8; ++dt) { const int dv = h * RDV + 16 * dt + 4 * g;
        const f32x4 gn = *(const f32x4*)(ret_gain + dv); const u32x2 gw = *(const u32x2*)(RGg + row * 512 + dv);
        const f32x4 gt = (f32x4){bflo(gw.x), bfhi(gw.x), bflo(gw.y), bfhi(gw.y)};
        const f32x4 y = o[dt] * rstd * gn * silu4(gt);
        u32x2 wv; wv.x = cvt_pk_bf16(y[0], y[1]); wv.y = cvt_pk_bf16(y[2], y[3]); *(u32x2*)(MIX + row * D + AW + dv) = wv; }
}
__device__ __forceinline__ void ret_out_phase(const Frame& F, unsigned char* ws, const float* ret_gain) {
    const bf16* RQg = (const bf16*)(ws + WS_RQ); const bf16* RKg = (const bf16*)(ws + WS_RK); const bf16* RVg = (const bf16*)(ws + WS_RV); const bf16* RGg = (const bf16*)(ws + WS_RG);
    const float* KVT = (const float*)(ws + WS_KVST); bf16* MIX = (bf16*)(ws + WS_MIXED);
    const int NU = BATCH * RH * 16, nr = (NU + F.G - 1) / F.G;
    int u = F.bid; bool have = u < NU;
    if (have) ret_prefetch(F, u, RKg, RVg, F.lds);
    for (int k = 0; k < nr; ++k) {
        const int un = (k + 1) * F.G + F.bid; const bool hn = (k + 1 < nr) && un < NU;
        bf16x8 qf0 = (bf16x8){0, 0, 0, 0, 0, 0, 0, 0}, qf1 = qf0;
        if (have) {
            const int qi = F.lane & 15, g = F.lane >> 4, b = u >> 6, h = (u >> 4) & 3, i = u & 15;
            const bf16* qp = RQg + ((size_t)b * SEQ + 128 * i + 16 * F.wave + qi) * 256 + h * RDK + 8 * g; qf0 = *(const bf16x8*)qp; qf1 = *(const bf16x8*)(qp + 32);
            if (i > 0) {
                const float G = __builtin_amdgcn_exp2f(128.0f * ret_lg(h));
                LAS unsigned char* sb = F.lds + (k & 1) * MIXBUF + 49152;
#pragma unroll
                for (int q4 = 0; q4 < 4; ++q4) { const int e4 = F.tid + 512 * q4, dv = e4 >> 4, c4 = e4 & 15;
                    f32x4 st = (f32x4){0.f, 0.f, 0.f, 0.f};
                    for (int j = 0; j < i; ++j) { const f32x4 kv = *(const f32x4*)(KVT + ((size_t)(u - i + j) * RDV + dv) * RDK + 4 * c4); st = (st + kv) * G; }
                    u32x2 wv; wv.x = cvt_pk_bf16(st[0], st[1]); wv.y = cvt_pk_bf16(st[2], st[3]);
                    *(LAS u32x2*)(sb + img128(dv, c4 >> 1) + (c4 & 1) * 8) = wv; }
            }
        }
        asm volatile("s_waitcnt vmcnt(0) lgkmcnt(0)" ::: "memory"); __syncthreads();
        if (hn) ret_prefetch(F, un, RKg, RVg, F.lds + ((k + 1) & 1) * MIXBUF);
        if (have) ret_out_compute(F, u, F.lds + (k & 1) * MIXBUF, qf0, qf1, RGg, ret_gain, MIX);
        u = un; have = hn;
    }
    asm volatile("s_waitcnt vmcnt(0) lgkmcnt(0)" ::: "memory"); __syncthreads();
}
__device__ __forceinline__ void merge_phase(const Frame& F, unsigned char* ws) {
    const bf16* AO = (const bf16*)(ws + WS_ATTO); const float* LS = (const float*)(ws + WS_LSE); bf16* MIX = (bf16*)(ws + WS_MIXED);
    for (int idx = F.bid * NTHR + F.tid; idx < M * NHEAD * 8; idx += F.G * NTHR) {
        const int row = idx >> 6, head = (idx >> 3) & 7, c = idx & 7;
        const float l0 = LS[(size_t)row * NHEAD + head], l1 = LS[(size_t)M * NHEAD + (size_t)row * NHEAD + head], l2 = LS[(size_t)2 * M * NHEAD + (size_t)row * NHEAD + head];
        const float mx = fmaxf(l0, fmaxf(l1, l2)); const float e0 = __expf(l0 - mx), e1 = __expf(l1 - mx), e2 = __expf(l2 - mx), inv = 1.0f / (e0 + e1 + e2);
        const size_t off = (size_t)row * AW + head * HD + c * 8;
        const u32x4 a = *(const u32x4*)(AO + off), bq = *(const u32x4*)(AO + (size_t)M * AW + off), cq = *(const u32x4*)(AO + (size_t)2 * M * AW + off);
        const float w0 = e0 * inv, w1 = e1 * inv, w2 = e2 * inv;
        u32x4 o;
        o.x = cvt_pk_bf16(w0 * bflo(a.x) + w1 * bflo(bq.x) + w2 * bflo(cq.x), w0 * bfhi(a.x) + w1 * bfhi(bq.x) + w2 * bfhi(cq.x));
        o.y = cvt_pk_bf16(w0 * bflo(a.y) + w1 * bflo(bq.y) + w2 * bflo(cq.y), w0 * bfhi(a.y) + w1 * bfhi(bq.y) + w2 * bfhi(cq.y));
        o.z = cvt_pk_bf16(w0 * bflo(a.z) + w1 * bflo(bq.z) + w2 * bflo(cq.z), w0 * bfhi(a.z) + w1 * bfhi(bq.z) + w2 * bfhi(cq.z));
        o.w = cvt_pk_bf16(w0 * bflo(a.w) + w1 * bflo(bq.w) + w2 * bflo(cq.w), w0 * bfhi(a.w) + w1 * bfhi(bq.w) + w2 * bfhi(cq.w));
        *(u32x4*)(MIX + (size_t)row * D + head * HD + c * 8) = o;
    }
}

__global__ void __launch_bounds__(256) naive_attn(const bf16* __restrict__ Q, const bf16* __restrict__ Kb, const bf16* __restrict__ V, const float* __restrict__ bias_tab, bf16* __restrict__ MIX) {
    const int idx = blockIdx.x * 256 + threadIdx.x, head = idx & 7, tok = idx >> 3, b = tok >> 11, t = tok & (SEQ - 1);
    float q[64], acc[64];
    { const u32x4* qp = (const u32x4*)(Q + (size_t)tok * AW + head * 64);
#pragma unroll
      for (int i = 0; i < 8; ++i) { const u32x4 w = qp[i]; q[8 * i] = bflo(w.x); q[8 * i + 1] = bfhi(w.x); q[8 * i + 2] = bflo(w.y); q[8 * i + 3] = bfhi(w.y); q[8 * i + 4] = bflo(w.z); q[8 * i + 5] = bfhi(w.z); q[8 * i + 6] = bflo(w.w); q[8 * i + 7] = bfhi(w.w); } }
#pragma unroll
    for (int i = 0; i < 64; ++i) acc[i] = 0.f;
    float mx = -3.0e38f, l = 0.f;
    for (int br = 0; br < 3; ++br) { const int d = br == 0 ? 1 : (br == 1 ? 4 : 16);
        for (int dl = 0; dl <= 128; ++dl) { const int tk = t - dl * d; if (tk < 0) break;
            const size_t ro = (size_t)(b * SEQ + tk) * AW + head * 64; const u32x4* kp = (const u32x4*)(Kb + ro); const u32x4* vp = (const u32x4*)(V + ro);
            float s = 0.f;
#pragma unroll
            for (int i = 0; i < 8; ++i) { const u32x4 w = kp[i]; s += q[8 * i] * bflo(w.x) + q[8 * i + 1] * bfhi(w.x) + q[8 * i + 2] * bflo(w.y) + q[8 * i + 3] * bfhi(w.y) + q[8 * i + 4] * bflo(w.z) + q[8 * i + 5] * bfhi(w.z) + q[8 * i + 6] * bflo(w.w) + q[8 * i + 7] * bfhi(w.w); }
            s += bias_tab[(int)T5_BUCKET[br][dl] * NHEAD + head];
            if (s > mx) { const float sc = expf(mx - s); l *= sc;
#pragma unroll
                for (int i = 0; i < 64; ++i) acc[i] *= sc;
                mx = s; }
            const float p = expf(s - mx); l += p;
#pragma unroll
            for (int i = 0; i < 8; ++i) { const u32x4 w = vp[i]; acc[8 * i] += p * bflo(w.x); acc[8 * i + 1] += p * bfhi(w.x); acc[8 * i + 2] += p * bflo(w.y); acc[8 * i + 3] += p * bfhi(w.y); acc[8 * i + 4] += p * bflo(w.z); acc[8 * i + 5] += p * bfhi(w.z); acc[8 * i + 6] += p * bflo(w.w); acc[8 * i + 7] += p * bfhi(w.w); }
        } }
    const float il = 1.0f / l; u32x4* op = (u32x4*)(MIX + (size_t)tok * D + head * 64);
#pragma unroll
    for (int i = 0; i < 8; ++i) { u32x4 w; w.x = cvt_pk_bf16(acc[8 * i] * il, acc[8 * i + 1] * il); w.y = cvt_pk_bf16(acc[8 * i + 2] * il, acc[8 * i + 3] * il); w.z = cvt_pk_bf16(acc[8 * i + 4] * il, acc[8 * i + 5] * il); w.w = cvt_pk_bf16(acc[8 * i + 6] * il, acc[8 * i + 7] * il); op[i] = w; }
}
__global__ void __launch_bounds__(128) naive_ret(const bf16* __restrict__ RQ, const bf16* __restrict__ RK, const bf16* __restrict__ RV, const bf16* __restrict__ RG, const float* __restrict__ ret_gain, bf16* __restrict__ MIX) {
    __shared__ float sred[4];
    const int bh = blockIdx.x, b = bh >> 2, h = bh & 3, dv = threadIdx.x, wv = dv >> 6;
    float st[64];
#pragma unroll
    for (int i = 0; i < 64; ++i) st[i] = 0.f;
    const float g128 = __builtin_amdgcn_exp2f(128.0f * ret_lg(h)), gn = ret_gain[h * RDV + dv];
    for (int t = 0; t < SEQ; ++t) { const size_t row = (size_t)b * SEQ + t;
        if ((t & 127) == 0 && t) {
#pragma unroll
            for (int i = 0; i < 64; ++i) st[i] *= g128; }
        const u32x4* kp = (const u32x4*)(RK + row * 256 + h * 64); const u32x4* qp = (const u32x4*)(RQ + row * 256 + h * 64);
        const float v = bf2f(RV[row * 512 + h * RDV + dv]), gt = bf2f(RG[row * 512 + h * RDV + dv]);
        float y = 0.f;
#pragma unroll
        for (int i = 0; i < 8; ++i) { const u32x4 kw = kp[i], qw = qp[i];
            st[8 * i] += bflo(kw.x) * v; y += bflo(qw.x) * st[8 * i]; st[8 * i + 1] += bfhi(kw.x) * v; y += bfhi(qw.x) * st[8 * i + 1];
            st[8 * i + 2] += bflo(kw.y) * v; y += bflo(qw.y) * st[8 * i + 2]; st[8 * i + 3] += bfhi(kw.y) * v; y += bfhi(qw.y) * st[8 * i + 3];
            st[8 * i + 4] += bflo(kw.z) * v; y += bflo(qw.z) * st[8 * i + 4]; st[8 * i + 5] += bfhi(kw.z) * v; y += bfhi(qw.z) * st[8 * i + 5];
            st[8 * i + 6] += bflo(kw.w) * v; y += bflo(qw.w) * st[8 * i + 6]; st[8 * i + 7] += bfhi(kw.w) * v; y += bfhi(qw.w) * st[8 * i + 7]; }
        float s1 = wave_sum(y); if ((dv & 63) == 0) sred[wv] = s1; __syncthreads(); const float mu = (sred[0] + sred[1]) * (1.0f / RDV);
        const float dd = y - mu; float s2 = wave_sum(dd * dd); if ((dv & 63) == 0) sred[2 + wv] = s2; __syncthreads(); const float var = (sred[2] + sred[3]) * (1.0f / RDV);
        const float o = dd * (1.0f / sqrtf(var + EPS)) * gn * silu_f(gt);
        MIX[row * D + AW + h * RDV + dv] = (bf16)f2bf(o);
        __syncthreads();
    }
}

#ifndef SITE_MASK
#define SITE_MASK 63
#endif
constexpr int PH_PRO = 0, PH_PER_LAYER = 10, NPH = 1 + 2 * PH_PER_LAYER;
struct Args { const float* in[19]; float* out; unsigned char* ws; int ph_lo, ph_hi, li, pad; };
__global__ void __launch_bounds__(NTHR, 2) fwd(Args args) {
    extern __shared__ __attribute__((aligned(16))) unsigned char lds[];
    Frame F; F.lds = (LAS unsigned char*)lds; F.tid = threadIdx.x; F.lane = F.tid & 63; F.wave = __builtin_amdgcn_readfirstlane(F.tid >> 6); F.G = gridDim.x; F.bid = blockIdx.x;
    volatile LAS unsigned* MISC = (volatile LAS unsigned*)(F.lds + MISC_OFF);
    Ptrs P; P.x = args.in[0]; P.c = args.in[1]; P.bias_tab = args.in[2]; P.norm_mix = args.in[3]; P.norm_ffn = args.in[4]; P.w_mod = args.in[5]; P.b_mod = args.in[6]; P.w_in = args.in[7];
    P.q_gain = args.in[8]; P.k_gain = args.in[9]; P.ret_gain = args.in[10]; P.w_out = args.in[11]; P.ffn_w1 = args.in[12]; P.ffn_w3 = args.in[13]; P.ffn_w2 = args.in[14]; P.router = args.in[15];
    P.moe_w1 = args.in[16]; P.moe_w3 = args.in[17]; P.moe_w2 = args.in[18]; P.out = args.out; P.ws = args.ws;
    unsigned char* ws = args.ws; gu32* ctl = (gu32*)(ws + WS_CTL);
    for (int u = F.tid; u < (LDS_BYTES - LDSCTL_OFF) / 4; u += NTHR) ((LAS unsigned*)(F.lds + LDSCTL_OFF))[u] = 0u;
    __syncthreads();
    XcdBarrier bar = xcd_barrier_post((unsigned*)(ctl + CW_BAR) + args.li * XCD_BAR_WORDS, MISC + 8);
    const int lo = args.ph_lo, hi = args.ph_hi;
#define IN(k) (lo <= (k) && (k) < hi)
#define SEAM(k) do { if (IN(k) && (k) + 1 < hi) xcd_barrier(bar); } while (0)

    if (IN(PH_PRO)) { p0_prologue(phase_frame(F), P); } SEAM(PH_PRO);

    float* MOD = (float*)(ws + WS_MOD);
    for (int l = 0; l < 2; ++l) {
        const int pb = 1 + l * PH_PER_LAYER;
        const float* modl = MOD + (size_t)l * BATCH * MODW;
        const float* xin = l == 0 ? P.x : (const float*)P.out;
        if (IN(pb + 0)) norm_phase(phase_frame(F), xin, P.norm_mix + l * D, modl, 0, 1, (bf16*)(ws + WS_H));
        SEAM(pb + 0);
        if (IN(pb + 1)) {
            pg8::Gemm g{(const bf16*)(ws + WS_H), (const bf16*)(ws + WS_WIN) + (size_t)l * NIN * D, M, NIN, D, nullptr}; pg8::StaticOrder S; S.init(M, NIN, F.G, F.bid);
            EpiInProj E{ws, P.q_gain + l * HD, P.k_gain + l * HD};

#if SITE_MASK & 1
pg8::gemm_phase<EpiInProj, pg8::StaticOrder, false>(F.lds + RING_OFF, g, S, E);
#endif

        }
        SEAM(pb + 1);
        if (IN(pb + 2)) { attn_phase(phase_frame(F), ws, P.bias_tab); ret_kv_phase(phase_frame(F), ws); }
        SEAM(pb + 2);
        if (IN(pb + 3)) { ret_out_phase(phase_frame(F), ws, P.ret_gain + l * AW); merge_phase(phase_frame(F), ws); }
        SEAM(pb + 3);
        if (IN(pb + 4)) {
            pg8::Gemm g{(const bf16*)(ws + WS_MIXED), (const bf16*)(ws + WS_WOUT) + (size_t)l * D * D, M, D, D, nullptr}; pg8::StaticOrder S; S.init(M, D, F.G, F.bid);
            EpiResid E{xin, P.out, modl + 2 * D};

#if SITE_MASK & 2
pg8::gemm_phase<EpiResid, pg8::StaticOrder, false>(F.lds + RING_OFF, g, S, E);
#endif

        }
        SEAM(pb + 4);
        if (IN(pb + 5)) {
            if (l == 0) norm_phase(phase_frame(F), P.out, P.norm_ffn + l * D, modl, 3, 4, (bf16*)(ws + WS_H));
            else norm_router_phase(phase_frame(F), P.out, P.norm_ffn + l * D, modl, 3, 4, (bf16*)(ws + WS_H), P.router, (int*)(ws + TOK_E), (float*)(ws + TOK_W), (int*)(ws + TOK_SLOT), (unsigned*)(ctl + CW_CNT));
        }
        SEAM(pb + 5);
        if (l == 1) {
            if (IN(pb + 6)) map_phase(phase_frame(F), (const unsigned*)(ctl + CW_CNT), (const int*)(ws + TOK_E), (const float*)(ws + TOK_W), (const int*)(ws + TOK_SLOT), (int*)(ws + TOK_DST), (int*)(ws + SORTED_TOK), (float*)(ws + SLOT_W));
            SEAM(pb + 6);
        }
        if (IN(pb + 7)) {
            if (l == 0) {
                pg8::Gemm g{(const bf16*)(ws + WS_H), (const bf16*)(ws + WS_F13), M, 2 * DFF, D, nullptr}; pg8::StaticOrder S; S.init(M, 2 * DFF, F.G, F.bid);
                EpiSwiglu E{(bf16*)(ws + WS_HID), DFF, 2 * DFF / 256};

#if SITE_MASK & 4
pg8::gemm_phase<EpiSwiglu, pg8::StaticOrder, false>(F.lds + RING_OFF, g, S, E);
#endif

            } else {
                pg8::Gemm g{(const bf16*)(ws + WS_H), (const bf16*)(ws + WS_MOE13), MAXSLOT, 2 * DFE, D, (const int*)(ws + SORTED_TOK)}; MoeOrder S; S.init((const unsigned*)(ctl + CW_CNT), 2 * DFE / 256, F.G, F.bid);
                EpiSwiglu E{(bf16*)(ws + WS_HID), DFE, 2 * DFE / 256};

#if SITE_MASK & 8
pg8::gemm_phase<EpiSwiglu, MoeOrder, true>(F.lds + RING_OFF, g, S, E);
#endif

            }
        }
        SEAM(pb + 7);
        if (IN(pb + 8)) {
            if (l == 0) {
                pg8::Gemm g{(const bf16*)(ws + WS_HID), (const bf16*)(ws + WS_F2), M, D, DFF, nullptr}; pg8::StaticOrder S; S.init(M, D, F.G, F.bid);
                EpiResid E{P.out, P.out, modl + 5 * D};

#if SITE_MASK & 16
pg8::gemm_phase<EpiResid, pg8::StaticOrder, false>(F.lds + RING_OFF, g, S, E);
#endif

            } else {
                pg8::Gemm g{(const bf16*)(ws + WS_HID), (const bf16*)(ws + WS_MOE2), MAXSLOT, D, DFE, nullptr}; MoeOrder S; S.init((const unsigned*)(ctl + CW_CNT), D / 256, F.G, F.bid);
                EpiMoe2 E{(bf16*)(ws + WS_Y), (const float*)(ws + SLOT_W)};

#if SITE_MASK & 32
pg8::gemm_phase<EpiMoe2, MoeOrder, false>(F.lds + RING_OFF, g, S, E);
#endif

            }
        }
        if (l == 1) {
            SEAM(pb + 8);
            if (IN(pb + 9)) combine_phase(phase_frame(F), P.out, modl + 5 * D, (const bf16*)(ws + WS_Y), (const int*)(ws + TOK_DST));
        } else { SEAM(pb + 8); }
    }
#undef IN
#undef SEAM
}

extern "C" void kernel_launch(void* const* d_in, const int* in_sizes, int n_in, void* d_out, int out_size, void* d_ws, size_t ws_size, hipStream_t stream) {
    static int grid = 0;
    if (grid == 0) {
        if (n_in != 19 || in_sizes[0] != M * D || out_size != M * D || ws_size < WS_END) { fprintf(stderr, "kernel_launch: unexpected problem (n_in %d, ws %zu); nothing launched\n", n_in, ws_size); grid = -1; return; }
        int dev = 0, cus = 0, per_cu = 0;
        if (hipGetDevice(&dev) != hipSuccess || hipDeviceGetAttribute(&cus, hipDeviceAttributeMultiprocessorCount, dev) != hipSuccess) { grid = -1; return; }
        if (hipFuncSetAttribute((const void*)fwd, hipFuncAttributeMaxDynamicSharedMemorySize, LDS_BYTES) != hipSuccess) { grid = -1; return; }
        if (hipOccupancyMaxActiveBlocksPerMultiprocessor(&per_cu, (const void*)fwd, NTHR, LDS_BYTES) != hipSuccess || per_cu < 1) fprintf(stderr, "kernel_launch: occupancy query says %d\n", per_cu);
        (void)hipGetLastError();
        grid = cus;
    }
    if (grid < 0) return;
    (void)hipMemsetAsync((char*)d_ws + WS_CTL, 0, CTL_ZERO_BYTES, stream);
    Args a{};
    for (int i = 0; i < 19; ++i) a.in[i] = (const float*)d_in[i];
    a.out = (float*)d_out; a.ws = (unsigned char*)d_ws; a.pad = 0;
    unsigned char* ws = (unsigned char*)d_ws;
    int li = 0;
    auto run = [&](int plo, int phi) { a.ph_lo = plo; a.ph_hi = phi; a.li = li++; hipLaunchKernelGGL(fwd, dim3(grid), dim3(NTHR), LDS_BYTES, stream, a); };
#ifndef MIXER_MODE
#define MIXER_MODE 0
#endif
#if MIXER_MODE == 0
    run(0, NPH);
#else
    for (int l = 0; l < 2; ++l) {
        const int pb = 1 + l * PH_PER_LAYER;
        run(l == 0 ? PH_PRO : pb, pb + 2);
#if MIXER_MODE == 1
        run(pb + 2, pb + 4);
#else
        run(pb + 2, pb + 4);
#if MIXER_MODE & 2
        hipLaunchKernelGGL(naive_attn, dim3(M * NHEAD / 256), dim3(256), 0, stream, (const bf16*)(ws + WS_Q), (const bf16*)(ws + WS_K), (const bf16*)(ws + WS_V), (const float*)d_in[2], (bf16*)(ws + WS_MIXED));
#endif
#if MIXER_MODE & 4
        hipLaunchKernelGGL(naive_ret, dim3(BATCH * RH), dim3(128), 0, stream, (const bf16*)(ws + WS_RQ), (const bf16*)(ws + WS_RK), (const bf16*)(ws + WS_RV), (const bf16*)(ws + WS_RG), (const float*)d_in[10] + l * AW, (bf16*)(ws + WS_MIXED));
#endif
#endif
        run(pb + 4, pb + 10);
    }
#endif
}
```

```cpp
#include <hip/hip_runtime.h>
#include <cstdio>
#include <cstdint>
#include <cmath>
namespace pg8 {
#define PG8_LAS __attribute__((address_space(3)))
typedef unsigned short bf16_t;
typedef short bf16x8 __attribute__((ext_vector_type(8)));
typedef float f32x4 __attribute__((ext_vector_type(4)));
typedef unsigned u32x4 __attribute__((ext_vector_type(4)));
constexpr int BM = 256, BK = 64, HALF = 128, HTB = HALF * BK * 2  , STAGE_BYTES = 8 * HTB, NXCD = 8, WGM = 8;

__host__ __device__ __forceinline__ int lds_byte(int r, int c) { const int st = (r >> 4) * 2 + (c >> 5), rr = r & 15, cc = c & 31, ob = rr * 64 + cc * 2; return st * 1024 + (ob ^ (((ob >> 9) & 1) << 5)); }
__host__ __device__ __forceinline__ void stage_rc(int b, int& R, int& C) { const int st = b / 1024, sb = b % 1024, swz = sb ^ (((sb >> 9) & 1) << 5); R = (st >> 1) * 16 + swz / 64; C = (st & 1) * 32 + (swz % 64) / 2; }
__host__ __device__ __forceinline__ int perm32(int rho) { const int n = rho >> 4, i = rho & 15; return 8 * (i >> 2) + 4 * n + (i & 3); }

struct Unit { int pm, pn; };
struct Gemm { const bf16_t* A; const bf16_t* Bt; int M, N, K; const int* rowidx; };

struct StaticOrder {
    int nM, nN, nwg, G, c;
    __host__ __device__ void init(int M, int N, int G_, int c_) { nM = M / BM; nN = N / BM; nwg = nM * nN; G = G_; c = c_; }
    __host__ __device__ bool next(int i, Unit& u) const {
        const long L = (long)i * G + c; if (L >= nwg) return false;
        int wgid = (int)L; { const int q = nwg / NXCD, r = nwg % NXCD, xcd = wgid % NXCD, off = wgid / NXCD; wgid = (xcd < r ? xcd * (q + 1) : r * (q + 1) + (xcd - r) * q) + off; }
        const int nig = WGM * nN, gid = wgid / nig, fm = gid * WGM, gsz = (nM - fm) < WGM ? (nM - fm) : WGM;
        u.pm = fm + ((wgid % nig) % gsz); u.pn = (wgid % nig) / gsz; return true;
    }
    __device__ __forceinline__ void a_ready(const Unit&) const {}
    __device__ __forceinline__ void done(const Unit&) const {}
};

__device__ __forceinline__ unsigned cvt_pk_bf16(float lo, float hi) { unsigned r; asm volatile("v_cvt_pk_bf16_f32 %0, %1, %2" : "=v"(r) : "v"(lo), "v"(hi)); return r; }
typedef float f32x2 __attribute__((ext_vector_type(2)));
template <class Epi, class Sched, bool GATHER>
__device__ __forceinline__ void gemm_phase(PG8_LAS unsigned char* lds, const Gemm g, const Sched& S, const Epi& E) {
    int tid_ = threadIdx.x; asm volatile("" : "+v"(tid_));
    const int tid = tid_, wid = __builtin_amdgcn_readfirstlane(tid >> 6), lane = tid & 63, wr = wid >> 2, wc = wid & 3, fr = lane & 15, fq = lane >> 4;
    const int K = g.K, nt = K / BK;
    const size_t kstep = (size_t)(BK * 2);
    const size_t hstep = (size_t)HALF * K * 2;
    const size_t tstep = 2 * hstep;
    int RA[2], CA2[2]; unsigned voffB[2];
#pragma unroll
    for (int i = 0; i < 2; ++i) { int R, C; stage_rc(tid * 16 + i * 8192, R, C); const int Rb = Epi::PERM ? ((R & ~31) + perm32(R & 31)) : R;
        RA[i] = R; CA2[i] = C * 2; voffB[i] = (unsigned)(Rb * K + C) * 2u; }
    unsigned cv00, cv01, cv10, cv11, nv00, nv01, nv10, nv11;
    const unsigned ldsw = (unsigned)wid * 1024u;
    const int aoff = lds_byte(wr * 64 + fr, fq * 8), boff = lds_byte(wc * 32 + fr, fq * 8);
#define PG8_SA(b, h) (((b) * 2 + (h)) * HTB)
#define PG8_SB(b, h) ((4 + (b) * 2 + (h)) * HTB)
#define PG8_STAGE(bufoff, gbase, voff) do { _Pragma("unroll") for (int _i = 0; _i < 2; ++_i) \
        __builtin_amdgcn_global_load_lds((const unsigned*)((const char*)(gbase) + (voff)[_i]), (PG8_LAS unsigned*)(lds + (bufoff) + ldsw + _i * 8192), 16, 0, 0); } while (0)
#define PG8_STAGEA(bufoff, gbase, v0, v1) do { \
        __builtin_amdgcn_global_load_lds((const unsigned*)((const char*)(gbase) + (v0)), (PG8_LAS unsigned*)(lds + (bufoff) + ldsw), 16, 0, 0); \
        __builtin_amdgcn_global_load_lds((const unsigned*)((const char*)(gbase) + (v1)), (PG8_LAS unsigned*)(lds + (bufoff) + ldsw + 8192), 16, 0, 0); } while (0)
#define PG8_LDA(dst, b, h) do { _Pragma("unroll") for (int m = 0; m < 4; ++m) _Pragma("unroll") for (int k = 0; k < 2; ++k) dst[m][k] = *(const PG8_LAS bf16x8*)(lds + PG8_SA(b, h) + aoff + m * 2048 + k * 1024); } while (0)
#define PG8_LDB(dst, b, h) do { _Pragma("unroll") for (int n = 0; n < 2; ++n) _Pragma("unroll") for (int k = 0; k < 2; ++k) dst[n][k] = *(const PG8_LAS bf16x8*)(lds + PG8_SB(b, h) + boff + n * 2048 + k * 1024); } while (0)
#define PG8_MMA(ai, bj, At, Bt) do { __builtin_amdgcn_s_setprio(1); _Pragma("unroll") for (int m = 0; m < 4; ++m) _Pragma("unroll") for (int n = 0; n < 2; ++n) _Pragma("unroll") for (int k = 0; k < 2; ++k) \
        acc[ai][bj][m][n] = __builtin_amdgcn_mfma_f32_16x16x32_bf16(Bt[n][k], At[m][k], acc[ai][bj][m][n], 0, 0, 0); __builtin_amdgcn_s_setprio(0); } while (0)
#define PG8_WAIT_V(n) asm volatile("s_waitcnt vmcnt(" #n ")" ::: "memory")
#define PG8_WAIT_L(n) asm volatile("s_waitcnt lgkmcnt(" #n ")" ::: "memory")
#define PG8_BAR __builtin_amdgcn_s_barrier()
#define PG8_SCHED __builtin_amdgcn_sched_barrier(0)
#define PG8_AOFFS(u, o00, o01, o10, o11) do { \
        if constexpr (GATHER) { const int* ri_ = g.rowidx + (size_t)(u).pm * BM; \
            const int r00 = ri_[RA[0]], r01 = ri_[RA[1]], r10 = ri_[HALF + RA[0]], r11 = ri_[HALF + RA[1]]; \
            o00 = (unsigned)r00 * (unsigned)(K * 2) + (unsigned)CA2[0]; o01 = (unsigned)r01 * (unsigned)(K * 2) + (unsigned)CA2[1]; \
            o10 = (unsigned)r10 * (unsigned)(K * 2) + (unsigned)CA2[0]; o11 = (unsigned)r11 * (unsigned)(K * 2) + (unsigned)CA2[1]; } \
        else { o00 = (unsigned)(RA[0] * K * 2 + CA2[0]); o01 = (unsigned)(RA[1] * K * 2 + CA2[1]); o10 = o00 + (unsigned)hstep; o11 = o01 + (unsigned)hstep; } } while (0)
    Unit cur, nxt; int ui = 0;
    if (!S.next(0, cur)) return;
    f32x4 acc[2][2][4][2];
#pragma unroll
    for (int a = 0; a < 2; ++a)
#pragma unroll
        for (int b = 0; b < 2; ++b)
#pragma unroll
            for (int m = 0; m < 4; ++m)
#pragma unroll
                for (int n = 0; n < 2; ++n) acc[a][b][m][n] = (f32x4){0.f, 0.f, 0.f, 0.f};
    bf16x8 At[4][2], B0[2][2], B1[2][2];
    const char* cA = GATHER ? (const char*)g.A : (const char*)g.A + (size_t)cur.pm * tstep; const char* cB = (const char*)g.Bt + (size_t)cur.pn * tstep;
    PG8_AOFFS(cur, cv00, cv01, cv10, cv11);
    if constexpr (GATHER) { asm volatile("s_waitcnt vmcnt(0)" ::: "memory"); }
    S.a_ready(cur);
    PG8_STAGE(PG8_SB(0, 0), cB, voffB); PG8_STAGE(PG8_SB(0, 1), cB + hstep, voffB); PG8_STAGEA(PG8_SA(0, 0), cA, cv00, cv01); PG8_STAGEA(PG8_SA(0, 1), cA, cv10, cv11);
    if (wr == 1) PG8_BAR;
    PG8_WAIT_V(2); PG8_BAR;
    PG8_STAGE(PG8_SB(1, 0), cB + kstep, voffB); PG8_STAGEA(PG8_SA(1, 0), cA + kstep, cv00, cv01); PG8_STAGE(PG8_SB(1, 1), cB + hstep + kstep, voffB);
    PG8_WAIT_V(6); PG8_BAR;
    for (;;) {
        const bool has_next = S.next(ui + 1, nxt);
        const char* nA = (has_next && !GATHER) ? (const char*)g.A + (size_t)nxt.pm * tstep : cA; const char* nB = has_next ? (const char*)g.Bt + (size_t)nxt.pn * tstep : cB;
        if constexpr (GATHER) {
            if (has_next) { PG8_AOFFS(nxt, nv00, nv01, nv10, nv11); } else { nv00 = cv00; nv01 = cv01; nv10 = cv10; nv11 = cv11; }
        } else { nv00 = cv00; nv01 = cv01; nv10 = cv10; nv11 = cv11; }
        for (int t = 0; t < nt; t += 2) {
            const bool last = (t == nt - 2);
            const char* a1 = cA + (size_t)(t + 1) * kstep;
            const char* a2 = last ? nA : cA + (size_t)(t + 2) * kstep; const char* b2 = last ? nB : cB + (size_t)(t + 2) * kstep;
            const char* a3 = a2 + kstep; const char* b3 = b2 + kstep;
            unsigned x00 = cv00, x01 = cv01, x10 = cv10, x11 = cv11;
            if constexpr (GATHER) { if (last) { x00 = nv00; x01 = nv01; x10 = nv10; x11 = nv11; } }
            if (last && has_next) S.a_ready(nxt);
            PG8_LDB(B0, 0, 0); PG8_LDB(B1, 0, 1); PG8_SCHED; PG8_LDA(At, 0, 0); PG8_STAGEA(PG8_SA(1, 1), a1, cv10, cv11);
            PG8_WAIT_V(8); PG8_WAIT_L(0); PG8_BAR; PG8_MMA(0, 0, At, B0); PG8_MMA(0, 1, At, B1); PG8_BAR; PG8_SCHED;
            PG8_LDA(At, 0, 1); PG8_STAGE(PG8_SB(0, 0), b2, voffB); PG8_STAGE(PG8_SB(0, 1), b2 + hstep, voffB); PG8_STAGEA(PG8_SA(0, 0), a2, x00, x01);
            PG8_WAIT_V(8); PG8_WAIT_L(0); PG8_BAR; PG8_MMA(1, 0, At, B0); PG8_MMA(1, 1, At, B1); PG8_BAR; PG8_SCHED;
            PG8_LDB(B0, 1, 0); PG8_LDB(B1, 1, 1); PG8_SCHED; PG8_LDA(At, 1, 0); PG8_STAGEA(PG8_SA(0, 1), a2, x10, x11);
            PG8_WAIT_V(8); PG8_WAIT_L(0); PG8_BAR; PG8_MMA(0, 0, At, B0); PG8_MMA(0, 1, At, B1); PG8_BAR; PG8_SCHED;
            PG8_LDA(At, 1, 1); PG8_STAGE(PG8_SB(1, 0), b3, voffB); PG8_STAGE(PG8_SB(1, 1), b3 + hstep, voffB); PG8_STAGEA(PG8_SA(1, 0), a3, x00, x01);
            PG8_WAIT_V(8); PG8_WAIT_L(0); PG8_BAR; PG8_MMA(1, 0, At, B0); PG8_MMA(1, 1, At, B1); PG8_BAR; PG8_SCHED;
        }
        if (wr == 0) PG8_BAR;
        E(acc, cur, wr, wc, fr, fq); S.done(cur);
        if (!has_next) break;
#pragma unroll
        for (int a = 0; a < 2; ++a)
#pragma unroll
            for (int b = 0; b < 2; ++b)
#pragma unroll
                for (int m = 0; m < 4; ++m)
#pragma unroll
                    for (int n = 0; n < 2; ++n) acc[a][b][m][n] = (f32x4){0.f, 0.f, 0.f, 0.f};
        cur = nxt; cA = nA; cB = nB; ++ui; cv00 = nv00; cv01 = nv01; cv10 = nv10; cv11 = nv11;
        if (wr == 1) PG8_BAR;
    }
    PG8_WAIT_V(0);
    PG8_BAR;
#undef PG8_SA
#undef PG8_SB
#undef PG8_STAGE
#undef PG8_STAGEA
#undef PG8_LDA
#undef PG8_LDB
#undef PG8_MMA
#undef PG8_WAIT_V
#undef PG8_WAIT_L
#undef PG8_BAR
#undef PG8_SCHED
#undef PG8_AOFFS
}
typedef int i32x8 __attribute__((ext_vector_type(8)));
template <class Epi, class Sched, bool GATHER>
__device__ __forceinline__ void gemm_phase_f8(PG8_LAS unsigned char* lds, const Gemm g, const Sched& S, const Epi& E) {
    int tid_ = threadIdx.x; asm volatile("" : "+v"(tid_));
    const int tid = tid_, wid = __builtin_amdgcn_readfirstlane(tid >> 6), lane = tid & 63, wr = wid >> 2, wc = wid & 3, fr = lane & 15, fq = lane >> 4;
    const int K = g.K, nt = K / 128;
    const size_t kstep = 128;
    const size_t hstep = (size_t)HALF * K;
    const size_t tstep = 2 * hstep;
    int RA[2], CA2[2]; unsigned voffB[2];
#pragma unroll
    for (int i = 0; i < 2; ++i) { int R, C; stage_rc(tid * 16 + i * 8192, R, C); const int Rb = Epi::PERM ? ((R & ~31) + perm32(R & 31)) : R;
        RA[i] = R; CA2[i] = C * 2; voffB[i] = (unsigned)(Rb * K + C * 2); }
    unsigned cv00, cv01, cv10, cv11, nv00, nv01, nv10, nv11;
    const unsigned ldsw = (unsigned)wid * 1024u;
    const int aoff = lds_byte(wr * 64 + fr, fq * 16), boff = lds_byte(wc * 32 + fr, fq * 16);
#define PG8_SA(b, h) (((b) * 2 + (h)) * HTB)
#define PG8_SB(b, h) ((4 + (b) * 2 + (h)) * HTB)
#define PG8_STAGE(bufoff, gbase, voff) do { _Pragma("unroll") for (int _i = 0; _i < 2; ++_i) \
        __builtin_amdgcn_global_load_lds((const unsigned*)((const char*)(gbase) + (voff)[_i]), (PG8_LAS unsigned*)(lds + (bufoff) + ldsw + _i * 8192), 16, 0, 0); } while (0)
#define PG8_STAGEA(bufoff, gbase, v0, v1) do { \
        __builtin_amdgcn_global_load_lds((const unsigned*)((const char*)(gbase) + (v0)), (PG8_LAS unsigned*)(lds + (bufoff) + ldsw), 16, 0, 0); \
        __builtin_amdgcn_global_load_lds((const unsigned*)((const char*)(gbase) + (v1)), (PG8_LAS unsigned*)(lds + (bufoff) + ldsw + 8192), 16, 0, 0); } while (0)
#define PG8_LDA(dst, b, h) do { _Pragma("unroll") for (int m = 0; m < 4; ++m) dst[m] = *(const PG8_LAS i32x8*)(lds + PG8_SA(b, h) + aoff + m * 2048); } while (0)
#define PG8_LDB(dst, b, h) do { _Pragma("unroll") for (int n = 0; n < 2; ++n) dst[n] = *(const PG8_LAS i32x8*)(lds + PG8_SB(b, h) + boff + n * 2048); } while (0)
#define PG8_MMA(ai, bj, At, Bt) do { __builtin_amdgcn_s_setprio(1); _Pragma("unroll") for (int m = 0; m < 4; ++m) _Pragma("unroll") for (int n = 0; n < 2; ++n) \
        asm volatile("v_mfma_scale_f32_16x16x128_f8f6f4 %0, %1, %2, %0, %3, %3 op_sel_hi:[0,0,0]" : "+v"(acc[ai][bj][m][n]) : "v"(Bt[n]), "v"(At[m]), "v"(unit_scale));     __builtin_amdgcn_s_setprio(0); } while (0)
#define PG8_WAIT_V(n) asm volatile("s_waitcnt vmcnt(" #n ")" ::: "memory")
#define PG8_WAIT_L(n) asm volatile("s_waitcnt lgkmcnt(" #n ")" ::: "memory")
#define PG8_BAR __builtin_amdgcn_s_barrier()
#define PG8_SCHED __builtin_amdgcn_sched_barrier(0)
#define PG8_AOFFS(u, o00, o01, o10, o11) do { \
        if constexpr (GATHER) { const int* ri_ = g.rowidx + (size_t)(u).pm * BM; \
            const int r00 = ri_[RA[0]], r01 = ri_[RA[1]], r10 = ri_[HALF + RA[0]], r11 = ri_[HALF + RA[1]]; \
            o00 = (unsigned)r00 * (unsigned)K + (unsigned)CA2[0]; o01 = (unsigned)r01 * (unsigned)K + (unsigned)CA2[1]; \
            o10 = (unsigned)r10 * (unsigned)K + (unsigned)CA2[0]; o11 = (unsigned)r11 * (unsigned)K + (unsigned)CA2[1]; } \
        else { o00 = (unsigned)(RA[0] * K + CA2[0]); o01 = (unsigned)(RA[1] * K + CA2[1]); o10 = o00 + (unsigned)hstep; o11 = o01 + (unsigned)hstep; } } while (0)
    Unit cur, nxt; int ui = 0;
    if (!S.next(0, cur)) return;
    f32x4 acc[2][2][4][2];
#pragma unroll
    for (int a = 0; a < 2; ++a)
#pragma unroll
        for (int b = 0; b < 2; ++b)
#pragma unroll
            for (int m = 0; m < 4; ++m)
#pragma unroll
                for (int n = 0; n < 2; ++n) acc[a][b][m][n] = (f32x4){0.f, 0.f, 0.f, 0.f};
    i32x8 At[4], B0[2], B1[2]; const int unit_scale = 0x7f7f7f7f;
    const char* cA = GATHER ? (const char*)g.A : (const char*)g.A + (size_t)cur.pm * tstep; const char* cB = (const char*)g.Bt + (size_t)cur.pn * tstep;
    PG8_AOFFS(cur, cv00, cv01, cv10, cv11);
    if constexpr (GATHER) { asm volatile("s_waitcnt vmcnt(0)" ::: "memory"); }
    S.a_ready(cur);
    PG8_STAGE(PG8_SB(0, 0), cB, voffB); PG8_STAGE(PG8_SB(0, 1), cB + hstep, voffB); PG8_STAGEA(PG8_SA(0, 0), cA, cv00, cv01); PG8_STAGEA(PG8_SA(0, 1), cA, cv10, cv11);
    if (wr == 1) PG8_BAR;
    PG8_WAIT_V(2); PG8_BAR;
    PG8_STAGE(PG8_SB(1, 0), cB + kstep, voffB); PG8_STAGEA(PG8_SA(1, 0), cA + kstep, cv00, cv01); PG8_STAGE(PG8_SB(1, 1), cB + hstep + kstep, voffB);
    PG8_WAIT_V(6); PG8_BAR;
    for (;;) {
        const bool has_next = S.next(ui + 1, nxt);
        const char* nA = (has_next && !GATHER) ? (const char*)g.A + (size_t)nxt.pm * tstep : cA; const char* nB = has_next ? (const char*)g.Bt + (size_t)nxt.pn * tstep : cB;
        if constexpr (GATHER) {
            if (has_next) { PG8_AOFFS(nxt, nv00, nv01, nv10, nv11); } else { nv00 = cv00; nv01 = cv01; nv10 = cv10; nv11 = cv11; }
        } else { nv00 = cv00; nv01 = cv01; nv10 = cv10; nv11 = cv11; }
        for (int t = 0; t < nt; t += 2) {
            const bool last = (t == nt - 2);
            const char* a1 = cA + (size_t)(t + 1) * kstep;
            const char* a2 = last ? nA : cA + (size_t)(t + 2) * kstep; const char* b2 = last ? nB : cB + (size_t)(t + 2) * kstep;
            const char* a3 = a2 + kstep; const char* b3 = b2 + kstep;
            unsigned x00 = cv00, x01 = cv01, x10 = cv10, x11 = cv11;
            if constexpr (GATHER) { if (last) { x00 = nv00; x01 = nv01; x10 = nv10; x11 = nv11; } }
            if (last && has_next) S.a_ready(nxt);
            PG8_LDB(B0, 0, 0); PG8_LDB(B1, 0, 1); PG8_SCHED; PG8_LDA(At, 0, 0); PG8_STAGEA(PG8_SA(1, 1), a1, cv10, cv11);
            PG8_WAIT_V(8); PG8_WAIT_L(0); PG8_BAR; PG8_MMA(0, 0, At, B0); PG8_MMA(0, 1, At, B1); PG8_BAR; PG8_SCHED;
            PG8_LDA(At, 0, 1); PG8_STAGE(PG8_SB(0, 0), b2, voffB); PG8_STAGE(PG8_SB(0, 1), b2 + hstep, voffB); PG8_STAGEA(PG8_SA(0, 0), a2, x00, x01);
            PG8_WAIT_V(8); PG8_WAIT_L(0); PG8_BAR; PG8_MMA(1, 0, At, B0); PG8_MMA(1, 1, At, B1); PG8_BAR; PG8_SCHED;
            PG8_LDB(B0, 1, 0); PG8_LDB(B1, 1, 1); PG8_SCHED; PG8_LDA(At, 1, 0); PG8_STAGEA(PG8_SA(0, 1), a2, x10, x11);
            PG8_WAIT_V(8); PG8_WAIT_L(0); PG8_BAR; PG8_MMA(0, 0, At, B0); PG8_MMA(0, 1, At, B1); PG8_BAR; PG8_SCHED;
            PG8_LDA(At, 1, 1); PG8_STAGE(PG8_SB(1, 0), b3, voffB); PG8_STAGE(PG8_SB(1, 1), b3 + hstep, voffB); PG8_STAGEA(PG8_SA(1, 0), a3, x00, x01);
            PG8_WAIT_V(8); PG8_WAIT_L(0); PG8_BAR; PG8_MMA(1, 0, At, B0); PG8_MMA(1, 1, At, B1); PG8_BAR; PG8_SCHED;
        }
        asm volatile("s_nop 15\n\ts_nop 15" ::: "memory");
        if (wr == 0) PG8_BAR;
        E(acc, cur, wr, wc, fr, fq); S.done(cur);
        if (!has_next) break;
#pragma unroll
        for (int a = 0; a < 2; ++a)
#pragma unroll
            for (int b = 0; b < 2; ++b)
#pragma unroll
                for (int m = 0; m < 4; ++m)
#pragma unroll
                    for (int n = 0; n < 2; ++n) acc[a][b][m][n] = (f32x4){0.f, 0.f, 0.f, 0.f};
        cur = nxt; cA = nA; cB = nB; ++ui; cv00 = nv00; cv01 = nv01; cv10 = nv10; cv11 = nv11;
        if (wr == 1) PG8_BAR;
    }
    PG8_WAIT_V(0);
    PG8_BAR;
#undef PG8_SA
#undef PG8_SB
#undef PG8_STAGE
#undef PG8_STAGEA
#undef PG8_LDA
#undef PG8_LDB
#undef PG8_MMA
#undef PG8_WAIT_V
#undef PG8_WAIT_L
#undef PG8_BAR
#undef PG8_SCHED
#undef PG8_AOFFS
}
}
#define GAS __attribute__((address_space(1)))
#define LAS __attribute__((address_space(3)))
typedef unsigned short bf16;
typedef unsigned v4u __attribute__((ext_vector_type(4)));
typedef float f32x4 __attribute__((ext_vector_type(4)));
typedef short bf16x8 __attribute__((ext_vector_type(8)));
typedef GAS unsigned gu32;
typedef GAS unsigned long long gu64;
#define RLX_AGENT __ATOMIC_RELAXED, __HIP_MEMORY_SCOPE_AGENT
#define LDS_WAIT() asm volatile("s_waitcnt lgkmcnt(0)" ::: "memory")
#define VM_WAIT() asm volatile("s_waitcnt vmcnt(0)" ::: "memory")
__device__ __forceinline__ unsigned long long rt() { return __builtin_amdgcn_s_memrealtime(); }
__device__ __forceinline__ unsigned f2bf(float f) { unsigned u = __builtin_bit_cast(unsigned, f); return (u + 0x7fffu + ((u >> 16) & 1u)) >> 16; }
__device__ __forceinline__ unsigned pk2(float lo, float hi) { return f2bf(lo) | (f2bf(hi) << 16); }

#define XB_TMO      128
#define XB_XCNT(j)  (256  + 64 * (j))
#define XB_XSUB(j)  (1280 + 64 * (j))
#define XB_XGEN(j)  (2304 + 64 * (j))
#define XB_TOP      3328
#define XB_TOPGEN   3392
#define XCD_BAR_WORDS 3456
#define XB_SPIN_CAP (1u << 18)

__device__ __forceinline__ unsigned xb_ld(unsigned* p)              { return __hip_atomic_load(p, __ATOMIC_RELAXED, __HIP_MEMORY_SCOPE_AGENT); }
__device__ __forceinline__ unsigned xb_add(unsigned* p, unsigned v) { return __hip_atomic_fetch_add(p, v, __ATOMIC_RELAXED, __HIP_MEMORY_SCOPE_AGENT); }
__device__ __forceinline__ unsigned xb_xcc_id() { return (unsigned)__builtin_amdgcn_s_getreg((3 << 11) | 20) & 0xFu; }
#define XB_SPIN(cond, bar) do { unsigned _sp = 0; while (cond) { __builtin_amdgcn_s_sleep(1); \
    if ((++_sp & 255u) == 0u) { if (xb_ld(&(bar)[XB_TMO])) break; if (_sp > XB_SPIN_CAP) { atomicAdd(&(bar)[XB_TMO], 1u); break; } } } } while (0)

struct XcdBarrier {
    unsigned* bar; unsigned x;
    volatile LAS unsigned* st;
};

__device__ __forceinline__ XcdBarrier xcd_barrier_post(unsigned* bar, volatile LAS unsigned* st) {
    XcdBarrier b; b.bar = bar; b.x = xb_xcc_id(); b.st = st;
    if (threadIdx.x == 0) (void)xb_add(&bar[XB_XCNT(b.x)], 1u);
    return b;
}
__device__ __forceinline__ void xcd_barrier_complete(unsigned* bar, unsigned x, unsigned& nloc, unsigned& nx) {
    const unsigned G = gridDim.x * gridDim.y * gridDim.z;
    unsigned sum, cnt, mine, sp = 0u;
    for (;;) {
        sum = 0u; cnt = 0u; mine = 0u;
#pragma unroll
        for (unsigned j = 0; j < 16; ++j) { const unsigned c = xb_ld(&bar[XB_XCNT(j)]); sum += c; cnt += (c > 0u) ? 1u : 0u; mine = (j == x) ? c : mine; }
        if (sum == G) break;
        __builtin_amdgcn_s_sleep(1);
        if ((++sp & 255u) == 0u) { if (xb_ld(&bar[XB_TMO])) break; if (sp > XB_SPIN_CAP) { atomicAdd(&bar[XB_TMO], 1u); break; } }
    }
    nloc = mine > 0u ? mine : 1u; nx = cnt > 0u ? cnt : 1u;
}

__device__ __forceinline__ void xcd_barrier(const XcdBarrier& b) {
    asm volatile("s_waitcnt vmcnt(0)" ::: "memory");
    __syncthreads();
    if (threadIdx.x == 0) {
        unsigned* bar = b.bar;
        __builtin_amdgcn_s_waitcnt(0);
        unsigned nloc = b.st[0], nx = b.st[1];
        if (nloc == 0u) { xcd_barrier_complete(bar, b.x, nloc, nx); b.st[0] = nloc; b.st[1] = nx; }
        const unsigned old = xb_add(&bar[XB_XSUB(b.x)], 1u);
        const unsigned gen = old / nloc;
        if (old + 1u == (gen + 1u) * nloc) {
            __builtin_amdgcn_fence(__ATOMIC_RELEASE, "agent");
            asm volatile("s_waitcnt vmcnt(0)" ::: "memory");
            const unsigned og = xb_add(&bar[XB_TOP], 1u);
            const unsigned tg = og / nx;
            if (og + 1u == (tg + 1u) * nx) xb_add(&bar[XB_TOPGEN], 1u);
            else XB_SPIN(xb_ld(&bar[XB_TOPGEN]) == tg, bar);
            __builtin_amdgcn_fence(__ATOMIC_ACQUIRE, "agent");
            xb_add(&bar[XB_XGEN(b.x)], 1u);
            asm volatile("s_waitcnt vmcnt(0)" ::: "memory");
        } else {
            XB_SPIN(xb_ld(&bar[XB_XGEN(b.x)]) == gen, bar);
            __builtin_amdgcn_fence(__ATOMIC_ACQUIRE, "agent");
            asm volatile("s_waitcnt vmcnt(0)" ::: "memory");
        }
    }
    __syncthreads();
}

constexpr int NWAVES = 8, NTHR = NWAVES * 64;
constexpr int BATCH = 8, SEQ = 2048, D = 1024, M = BATCH * SEQ;
constexpr int NIN = 3072, AW = 512, NHEAD = 8, HD = 64, RH = 4, RDK = 64, RDV = 128;
constexpr int DFF = 2816, NE = 8, DFE = 3584;
constexpr int MODW = 6 * D;
constexpr int MAXTILES = 136, MAXSLOT = MAXTILES * 256;
constexpr float EPS = 1e-6f;

constexpr size_t MiB = 1u << 20;
constexpr size_t WS_CTL = 0, CTL_ZERO_BYTES = 1 * MiB;
constexpr size_t WS_MOD = 1 * MiB;
constexpr size_t WS_ROPE = WS_MOD + 512 * 1024;
constexpr size_t WS_TOK = 2 * MiB;
constexpr size_t TOK_E = WS_TOK, TOK_W = TOK_E + 131072, TOK_SLOT = TOK_W + 131072, TOK_DST = TOK_SLOT + 131072, SORTED_TOK = TOK_DST + 131072, SLOT_W = SORTED_TOK + MAXSLOT * 4;
static_assert(SLOT_W + MAXSLOT * 4 <= 3 * MiB, "tok tables");
constexpr size_t WS_MOE13 = 3 * MiB;
constexpr size_t WS_MOE2 = 115 * MiB;
constexpr size_t WS_WIN = 171 * MiB;
constexpr size_t WS_WOUT = 183 * MiB;
constexpr size_t WS_F13 = 187 * MiB;
constexpr size_t WS_F2 = 198 * MiB;
constexpr size_t WS_H = 204 * MiB;
constexpr size_t WS_Y = 171 * MiB;
constexpr size_t WS_ARENA = 240 * MiB;
constexpr size_t WS_Q = WS_ARENA, WS_K = WS_ARENA + 16 * MiB, WS_V = WS_ARENA + 32 * MiB, WS_RQ = WS_ARENA + 48 * MiB, WS_RK = WS_ARENA + 56 * MiB,
                 WS_RV = WS_ARENA + 64 * MiB, WS_RG = WS_ARENA + 80 * MiB, WS_ATTO = WS_ARENA + 96 * MiB, WS_LSE = WS_ARENA + 144 * MiB,
                 WS_KVST = WS_ARENA + 146 * MiB, WS_MIXED = WS_ARENA + 162 * MiB;
constexpr size_t WS_STATE = WS_ARENA + 194 * MiB;
constexpr size_t WS_HID = WS_ARENA;
constexpr float F8_H = 16.0f, F8_W13 = 256.0f, F8_HID = 8.0f, F8_W2 = 512.0f;
constexpr size_t WS_END = 478 * MiB;
static_assert(WS_Y + (size_t)MAXSLOT * D * 2 <= WS_ARENA && WS_HID + (size_t)MAXSLOT * DFE * 2 <= WS_END && WS_MIXED + 32 * MiB <= WS_END, "ws map");
constexpr int CW_TMO = 0, CW_CODE = 1;
constexpr int CW_CNT = 8192;
constexpr int CW_BAR = 16384;
constexpr int MAX_BAR_REGIONS = 24;
static_assert((CW_BAR + MAX_BAR_REGIONS * XCD_BAR_WORDS) * 4 <= (int)CTL_ZERO_BYTES, "CTL words inside the memset region");

constexpr int RING_OFF = 0, RING_BYTES = 131072;
constexpr int LDSCTL_OFF = RING_BYTES, MISC_OFF = LDSCTL_OFF + 320;
constexpr int LDS_BYTES = 151552;
static_assert(MISC_OFF + 128 <= LDS_BYTES, "LDS map");

__device__ const unsigned char T5_BUCKET[3][132] = {
{0,1,2,3,4,5,6,7,8,9,10,11,12,13,14,15,16,16,16,16,16,16,17,17,17,17,17,17,17,17,18,18,18,18,18,18,18,18,18,18,19,19,19,19,19,19,19,19,19,19,19,19,19,19,20,20,20,20,20,20,20,20,20,20,20,20,20,20,20,20,20,20,20,21,21,21,21,21,21,21,21,21,21,21,21,21,21,21,21,21,21,21,21,21,21,21,21,21,21,22,22,22,22,22,22,22,22,22,22,22,22,22,22,22,22,22,22,22,22,22,22,22,22,22,22,22,22,22,22,0,0,0},
{0,4,8,12,16,16,17,17,18,18,19,19,19,19,20,20,20,20,20,21,21,21,21,21,21,22,22,22,22,22,22,22,22,22,23,23,23,23,23,23,23,23,23,23,23,23,24,24,24,24,24,24,24,24,24,24,24,24,24,24,24,24,25,25,25,25,25,25,25,25,25,25,25,25,25,25,25,25,25,25,25,25,25,26,26,26,26,26,26,26,26,26,26,26,26,26,26,26,26,26,26,26,26,26,26,26,26,26,26,26,26,26,26,27,27,27,27,27,27,27,27,27,27,27,27,27,27,27,27,0,0,0},
{0,16,18,19,20,21,21,22,22,23,23,23,24,24,24,24,25,25,25,25,25,26,26,26,26,26,26,26,26,27,27,27,27,27,27,27,27,27,27,28,28,28,28,28,28,28,28,28,28,28,28,28,29,29,29,29,29,29,29,29,29,29,29,29,29,29,29,29,29,29,30,30,30,30,30,30,30,30,30,30,30,30,30,30,30,30,30,30,30,30,30,30,30,30,30,31,31,31,31,31,31,31,31,31,31,31,31,31,31,31,31,31,31,31,31,31,31,31,31,31,31,31,31,31,31,31,31,31,31,0,0,0}};

using pg8::Unit; using pg8::cvt_pk_bf16; using pg8::u32x4;
typedef unsigned u32x2 __attribute__((ext_vector_type(2)));
__device__ __forceinline__ float wave_sum(float v) {
#pragma unroll
    for (int o = 1; o < 64; o <<= 1) v += __shfl_xor(v, o);
    return v;
}
__device__ __forceinline__ float bf2f(unsigned short h) { return __builtin_bit_cast(float, (unsigned)h << 16); }
__device__ __forceinline__ float bflo(unsigned w) { return __builtin_bit_cast(float, w << 16); }
__device__ __forceinline__ float bfhi(unsigned w) { return __builtin_bit_cast(float, w & 0xffff0000u); }
__device__ __forceinline__ void st8(bf16* p, f32x4 a, f32x4 b) {
    u32x4 w; w.x = cvt_pk_bf16(a[0], a[1]); w.y = cvt_pk_bf16(a[2], a[3]); w.z = cvt_pk_bf16(b[0], b[1]); w.w = cvt_pk_bf16(b[2], b[3]); *(u32x4*)p = w; }
__device__ __forceinline__ float clamp8(float x) { return fminf(fmaxf(x, -448.0f), 448.0f); }
__device__ __forceinline__ unsigned pk4_fp8(float a, float b, float c, float d) { int w = 0; w = __builtin_amdgcn_cvt_pk_fp8_f32(clamp8(a), clamp8(b), w, false); w = __builtin_amdgcn_cvt_pk_fp8_f32(clamp8(c), clamp8(d), w, true); return (unsigned)w; }
__device__ __forceinline__ float silu_f(float x) { return x * __builtin_amdgcn_rcpf(1.0f + __builtin_amdgcn_exp2f(-1.4426950408889634f * x)); }
__device__ __forceinline__ f32x4 silu4(f32x4 x) { return (f32x4){silu_f(x[0]), silu_f(x[1]), silu_f(x[2]), silu_f(x[3])}; }
__device__ __forceinline__ float ret_lg(int h) { return __builtin_log2f(1.0f - __builtin_amdgcn_exp2f(-5.0f - (float)h)); }

struct EpiInProj {
    static constexpr bool PERM = true, AFTER_DRAIN = false;
    unsigned char* wsb; const float *qg, *kg;
    __device__ __forceinline__ void operator()(const f32x4 (&acc)[2][2][4][2], const Unit& u, int wr, int wc, int fr, int fq) const {
        const int pn = u.pn, row0 = u.pm * pg8::BM + wr * 64 + fr;
        if (pn < 4) {
            const bool isq = pn < 2; const float* gp = isq ? qg : kg; bf16* dst = (bf16*)(wsb + (isq ? WS_Q : WS_K)); const float sc = isq ? 0.125f : 1.0f;
            const int head = 4 * (pn & 1) + wc;
            f32x4 gv[2][2];
#pragma unroll
            for (int bj = 0; bj < 2; ++bj)
#pragma unroll
                for (int n = 0; n < 2; ++n) gv[bj][n] = *(const f32x4*)(gp + 32 * bj + 8 * fq + 4 * n);
#pragma unroll
            for (int ai = 0; ai < 2; ++ai)
#pragma unroll
                for (int m = 0; m < 4; ++m) {
                    float ss = 0.f;
#pragma unroll
                    for (int bj = 0; bj < 2; ++bj)
#pragma unroll
                        for (int n = 0; n < 2; ++n) { const f32x4 x = acc[ai][bj][m][n]; ss += (x[0] * x[0] + x[1] * x[1]) + (x[2] * x[2] + x[3] * x[3]); }
                    ss += __shfl_xor(ss, 16); ss += __shfl_xor(ss, 32);
                    const float r = __builtin_amdgcn_rsqf(ss * (1.0f / 64.0f) + EPS) * sc;
                    bf16* rp = dst + (size_t)(row0 + ai * pg8::HALF + m * 16) * AW + head * 64 + 8 * fq;
#pragma unroll
                    for (int bj = 0; bj < 2; ++bj) st8(rp + 32 * bj, acc[ai][bj][m][0] * r * gv[bj][0], acc[ai][bj][m][1] * r * gv[bj][1]);
                }
        } else if (pn == 6 || pn == 7) {
            const bool isq = pn == 6; bf16* dst = (bf16*)(wsb + (isq ? WS_RQ : WS_RK)); const int head = wc; const float lg = ret_lg(head);
            const float* cosT = (const float*)(wsb + WS_ROPE); const float* sinT = cosT + SEQ * 32;
#pragma unroll
            for (int ai = 0; ai < 2; ++ai)
#pragma unroll
                for (int m = 0; m < 4; ++m) {
                    const int row = row0 + ai * pg8::HALF + m * 16, pos = row & (SEQ - 1); const float p = (float)(pos & 127);
                    const float sc = isq ? 0.125f * __builtin_amdgcn_exp2f(p * lg) : __builtin_amdgcn_exp2f(-p * lg);
                    const float* cp = cosT + pos * 32 + 8 * fq; const float* sp = sinT + pos * 32 + 8 * fq;
                    const f32x4 c0 = *(const f32x4*)cp, c1 = *(const f32x4*)(cp + 4), s0 = *(const f32x4*)sp, s1 = *(const f32x4*)(sp + 4);
                    const f32x4 a0 = acc[ai][0][m][0], a1 = acc[ai][0][m][1], b0 = acc[ai][1][m][0], b1 = acc[ai][1][m][1];
                    bf16* rp = dst + (size_t)row * 256 + head * 64 + 8 * fq;
                    st8(rp, (a0 * c0 - b0 * s0) * sc, (a1 * c1 - b1 * s1) * sc);
                    st8(rp + 32, (a0 * s0 + b0 * c0) * sc, (a1 * s1 + b1 * c1) * sc);
                }
        } else {
            size_t doff; int col0;
            if (pn < 6) { doff = WS_V; col0 = (pn - 4) * 256; } else if (pn < 10) { doff = WS_RV; col0 = (pn - 8) * 256; } else { doff = WS_RG; col0 = (pn - 10) * 256; }
            bf16* dst = (bf16*)(wsb + doff);
            col0 += wc * 32 + 8 * fq;
#pragma unroll
            for (int ai = 0; ai < 2; ++ai)
#pragma unroll
                for (int m = 0; m < 4; ++m) { bf16* rp = dst + (size_t)(row0 + ai * pg8::HALF + m * 16) * 512 + col0;
#pragma unroll
                    for (int bj = 0; bj < 2; ++bj) st8(rp + bj * pg8::HALF, acc[ai][bj][m][0], acc[ai][bj][m][1]); }
        }
    }
};
struct EpiResid {
    static constexpr bool PERM = false, AFTER_DRAIN = false;
    const float* base; float* out; const float* gate;
    __device__ __forceinline__ void operator()(const f32x4 (&acc)[2][2][4][2], const Unit& u, int wr, int wc, int fr, int fq) const {
        const int row0 = u.pm * pg8::BM + wr * 64 + fr, col0 = u.pn * pg8::BM + wc * 32 + 4 * fq, b = u.pm >> 3;
        f32x4 gv[2][2];
#pragma unroll
        for (int bj = 0; bj < 2; ++bj)
#pragma unroll
            for (int n = 0; n < 2; ++n) gv[bj][n] = *(const f32x4*)(gate + (size_t)b * MODW + col0 + bj * pg8::HALF + n * 16);
#pragma unroll
        for (int ai = 0; ai < 2; ++ai)
#pragma unroll
            for (int m = 0; m < 4; ++m) { const size_t off = (size_t)(row0 + ai * pg8::HALF + m * 16) * D + col0;
#pragma unroll
                for (int bj = 0; bj < 2; ++bj)
#pragma unroll
                    for (int n = 0; n < 2; ++n) { const f32x4 xv = *(const f32x4*)(base + off + bj * pg8::HALF + n * 16); *(f32x4*)(out + off + bj * pg8::HALF + n * 16) = xv + gv[bj][n] * acc[ai][bj][m][n]; } }
    }
};
struct EpiSwigluF8 {
    static constexpr bool PERM = true, AFTER_DRAIN = false;
    unsigned char* Hd; int ldh, ntn;
    __device__ __forceinline__ void operator()(const f32x4 (&acc)[2][2][4][2], const Unit& u, int wr, int wc, int fr, int fq) const {
        const int pnl = u.pn % ntn, row0 = u.pm * pg8::BM + wr * 64 + fr, col0 = pnl * 128 + wc * 32 + 8 * fq; const float ci = 1.0f / (F8_H * F8_W13);
#pragma unroll
        for (int ai = 0; ai < 2; ++ai)
#pragma unroll
            for (int m = 0; m < 4; ++m) { const f32x4 h0 = silu4(acc[ai][0][m][0] * ci) * (acc[ai][1][m][0] * (ci * F8_HID)), h1 = silu4(acc[ai][0][m][1] * ci) * (acc[ai][1][m][1] * (ci * F8_HID));
                u32x2 wv; wv.x = pk4_fp8(h0[0], h0[1], h0[2], h0[3]); wv.y = pk4_fp8(h1[0], h1[1], h1[2], h1[3]);
                *(u32x2*)(Hd + (size_t)(row0 + ai * pg8::HALF + m * 16) * ldh + col0) = wv; }
    }
};
struct EpiSwiglu {
    static constexpr bool PERM = true, AFTER_DRAIN = false;
    bf16* Hd; int ldh, ntn;
    __device__ __forceinline__ void operator()(const f32x4 (&acc)[2][2][4][2], const Unit& u, int wr, int wc, int fr, int fq) const {
        const int pnl = u.pn % ntn, row0 = u.pm * pg8::BM + wr * 64 + fr, col0 = pnl * 128 + wc * 32 + 8 * fq;
#pragma unroll
        for (int ai = 0; ai < 2; ++ai)
#pragma unroll
            for (int m = 0; m < 4; ++m)
                st8(Hd + (size_t)(row0 + ai * pg8::HALF + m * 16) * ldh + col0, silu4(acc[ai][0][m][0]) * acc[ai][1][m][0], silu4(acc[ai][0][m][1]) * acc[ai][1][m][1]);
    }
};
struct EpiMoe2 {
    static constexpr bool PERM = true, AFTER_DRAIN = false;
    bf16* Y; const float* slot_w;
    __device__ __forceinline__ void operator()(const f32x4 (&acc)[2][2][4][2], const Unit& u, int wr, int wc, int fr, int fq) const {
        const int pnl = u.pn & 3, row0 = u.pm * pg8::BM + wr * 64 + fr, col0 = pnl * 256 + wc * 32 + 8 * fq;
#pragma unroll
        for (int ai = 0; ai < 2; ++ai)
#pragma unroll
            for (int m = 0; m < 4; ++m) { const int row = row0 + ai * pg8::HALF + m * 16; const float w = slot_w[row] * (1.0f / (F8_HID * F8_W2));
#pragma unroll
                for (int bj = 0; bj < 2; ++bj) st8(Y + (size_t)row * D + col0 + bj * pg8::HALF, acc[ai][bj][m][0] * w, acc[ai][bj][m][1] * w); }
    }
};
struct MoeOrder {
    int t0, t1, t2, t3, t4, t5, t6, t7, t8; int ntn, G, c;
    __device__ __forceinline__ void init(const unsigned* cnt, int ntn_, int G_, int c_) {
        ntn = ntn_; G = G_; c = c_;
        t0 = 0; t1 = t0 + (int)((cnt[0] + 255u) >> 8); t2 = t1 + (int)((cnt[64] + 255u) >> 8); t3 = t2 + (int)((cnt[128] + 255u) >> 8); t4 = t3 + (int)((cnt[192] + 255u) >> 8);
        t5 = t4 + (int)((cnt[256] + 255u) >> 8); t6 = t5 + (int)((cnt[320] + 255u) >> 8); t7 = t6 + (int)((cnt[384] + 255u) >> 8); t8 = t7 + (int)((cnt[448] + 255u) >> 8);
    }
    __device__ __forceinline__ bool next(int i, Unit& u) const {
        const int L = i * G + c; if (L >= t8 * ntn) return false;
        int e = 0, lo = 0, hi = t1;
        if (L >= t1 * ntn) { e = 1; lo = t1; hi = t2; }
        if (L >= t2 * ntn) { e = 2; lo = t2; hi = t3; }
        if (L >= t3 * ntn) { e = 3; lo = t3; hi = t4; }
        if (L >= t4 * ntn) { e = 4; lo = t4; hi = t5; }
        if (L >= t5 * ntn) { e = 5; lo = t5; hi = t6; }
        if (L >= t6 * ntn) { e = 6; lo = t6; hi = t7; }
        if (L >= t7 * ntn) { e = 7; lo = t7; hi = t8; }
        const int te = hi - lo, loc = L - lo * ntn, j = loc / te, r = loc - j * te;
        u.pm = lo + r; u.pn = e * ntn + j; return true;
    }
    __device__ __forceinline__ void a_ready(const Unit&) const {}
    __device__ __forceinline__ void done(const Unit&) const {}
};

struct Frame { LAS unsigned char* lds; int tid, lane, wave, G, bid; };
__device__ __forceinline__ Frame phase_frame(const Frame& F) { Frame f = F; asm volatile("" : "+v"(f.tid)); f.lane = f.tid & 63; return f; }

__device__ __forceinline__ void transpose_item(const float* W, int K, int N, bf16* WT, int drow0, LAS float* scr, int k0, int n0, int lane) {
#pragma unroll 8
    for (int i = 0; i < 32; ++i) { const int kk = 2 * i + (lane >> 5); scr[kk * 33 + (lane & 31)] = W[(size_t)(k0 + kk) * N + n0 + (lane & 31)]; }
    LDS_WAIT(); asm volatile("" ::: "memory");
    const int c = lane & 7;
#pragma unroll
    for (int j = 0; j < 4; ++j) { const int n = (lane >> 3) + 8 * j; const LAS float* s = scr + (8 * c) * 33 + n;
        v4u o; o.x = pk2(s[0 * 33], s[1 * 33]); o.y = pk2(s[2 * 33], s[3 * 33]); o.z = pk2(s[4 * 33], s[5 * 33]); o.w = pk2(s[6 * 33], s[7 * 33]);
        *(GAS v4u*)(WT + (size_t)(drow0 + n) * K + k0 + 8 * c) = o; }
    LDS_WAIT(); asm volatile("" ::: "memory");
}
__device__ __forceinline__ void transpose_item_f8(const float* W, int K, int N, unsigned char* WT, int drow0, LAS float* scr, int k0, int n0, int lane, float scale) {
#pragma unroll 8
    for (int i = 0; i < 32; ++i) { const int kk = 2 * i + (lane >> 5); scr[kk * 33 + (lane & 31)] = W[(size_t)(k0 + kk) * N + n0 + (lane & 31)]; }
    LDS_WAIT(); asm volatile("" ::: "memory");
    const int n = lane >> 1, kh = (lane & 1) * 32; const LAS float* s = scr + kh * 33 + n;
    v4u o0, o1;
    o0.x = pk4_fp8(s[0 * 33] * scale, s[1 * 33] * scale, s[2 * 33] * scale, s[3 * 33] * scale); o0.y = pk4_fp8(s[4 * 33] * scale, s[5 * 33] * scale, s[6 * 33] * scale, s[7 * 33] * scale);
    o0.z = pk4_fp8(s[8 * 33] * scale, s[9 * 33] * scale, s[10 * 33] * scale, s[11 * 33] * scale); o0.w = pk4_fp8(s[12 * 33] * scale, s[13 * 33] * scale, s[14 * 33] * scale, s[15 * 33] * scale);
    o1.x = pk4_fp8(s[16 * 33] * scale, s[17 * 33] * scale, s[18 * 33] * scale, s[19 * 33] * scale); o1.y = pk4_fp8(s[20 * 33] * scale, s[21 * 33] * scale, s[22 * 33] * scale, s[23 * 33] * scale);
    o1.z = pk4_fp8(s[24 * 33] * scale, s[25 * 33] * scale, s[26 * 33] * scale, s[27 * 33] * scale); o1.w = pk4_fp8(s[28 * 33] * scale, s[29 * 33] * scale, s[30 * 33] * scale, s[31 * 33] * scale);
    GAS v4u* dst = (GAS v4u*)(WT + (size_t)(drow0 + n) * K + k0 + kh); dst[0] = o0; dst[1] = o1;
    LDS_WAIT(); asm volatile("" ::: "memory");
}
__device__ __forceinline__ int inproj_dst_row(int n0) {
    const int pn = n0 >> 8, c = n0 & 255;
    const bool perm = (pn < 4) || pn == 6 || pn == 7;
    if (!perm) return n0;
    return (pn << 8) + 128 * ((c >> 5) & 1) + 32 * (c >> 6);
}
__device__ __forceinline__ int swiglu_dst_row(int n0, int second) { return 256 * (n0 >> 7) + (n0 & 127) + 128 * second; }

struct Ptrs {
    const float *x, *c, *bias_tab, *norm_mix, *norm_ffn, *w_mod, *b_mod, *w_in, *q_gain, *k_gain, *ret_gain, *w_out, *ffn_w1, *ffn_w3, *ffn_w2, *router, *moe_w1, *moe_w3, *moe_w2;
    float* out; unsigned char* ws;
};

__device__ __forceinline__ void p0_prologue(const Frame& F, const Ptrs& P) {
    unsigned char* ws = P.ws;
    {
        LAS float* cact = (LAS float*)(F.lds);
        LAS float* red = (LAS float*)(F.lds + 32768);
        for (int i = F.tid; i < BATCH * D; i += NTHR) { const int b = i >> 10, k = i & 1023; cact[k * 8 + b] = silu_f(P.c[i]); }
        __syncthreads();
        float* MOD = (float*)(ws + WS_MOD);
        for (int it = F.bid; it < 2 * (MODW / 64); it += F.G) {
            const int l = it / (MODW / 64), cc = it % (MODW / 64), col = cc * 64 + F.lane;
            const float* Wp = P.w_mod + (size_t)l * D * MODW + col;
            float a[8];
#pragma unroll
            for (int b = 0; b < 8; ++b) a[b] = 0.f;
            const int kb = F.wave * 128;
#pragma unroll 8
            for (int k = 0; k < 128; ++k) { const float w = Wp[(size_t)(kb + k) * MODW]; const f32x4 c0 = *(const LAS f32x4*)(cact + (kb + k) * 8), c1 = *(const LAS f32x4*)(cact + (kb + k) * 8 + 4);
                a[0] += c0[0] * w; a[1] += c0[1] * w; a[2] += c0[2] * w; a[3] += c0[3] * w; a[4] += c1[0] * w; a[5] += c1[1] * w; a[6] += c1[2] * w; a[7] += c1[3] * w; }
#pragma unroll
            for (int b = 0; b < 8; ++b) red[(F.wave * 8 + b) * 64 + F.lane] = a[b];
            __syncthreads();
            { const int b = F.wave, ln = F.lane; float s = 0.f;
#pragma unroll
              for (int w = 0; w < 8; ++w) s += red[(w * 8 + b) * 64 + ln];
              MOD[(size_t)l * BATCH * MODW + (size_t)b * MODW + cc * 64 + ln] = s + P.b_mod[l * MODW + cc * 64 + ln]; }
            __syncthreads();
        }
    }
    {
        float* cosT = (float*)(ws + WS_ROPE); float* sinT = cosT + SEQ * 32;
        for (int i = F.bid * NTHR + F.tid; i < SEQ * 32; i += F.G * NTHR) { const int pos = i >> 5, j = i & 31;
            const float inv = powf(10000.0f, -(float)j / 32.0f), ang = (float)pos * inv; float s, c; sincosf(ang, &s, &c); cosT[i] = c; sinT[i] = s; }
    }
    {
        LAS float* scr = (LAS float*)(F.lds + F.wave * 16384);
        const int gw = F.bid * NWAVES + F.wave, NGW = F.G * NWAVES;
        constexpr int I_IN = 16 * 96, I_OUT = 16 * 32, I_F13 = 16 * 88, I_F2 = 44 * 32, I_M13 = 16 * 112, I_M2 = 56 * 32;
        constexpr int B0 = 0, B1 = B0 + 2 * I_IN, B2 = B1 + 2 * I_OUT, B3 = B2 + 2 * I_F13, B4 = B3 + I_F2, B5 = B4 + 16 * I_M13, NITEMS = B5 + 8 * I_M2;
        __syncthreads();
        for (int it = gw; it < NITEMS; it += NGW) {
            if (it < B1) { const int l = it / I_IN, r = it % I_IN, kb = r / 96, nb = r % 96;
                transpose_item(P.w_in + (size_t)l * D * NIN, D, NIN, (bf16*)(ws + WS_WIN) + (size_t)l * NIN * D, inproj_dst_row(32 * nb), scr, 64 * kb, 32 * nb, F.lane); }
            else if (it < B2) { const int q = it - B1, l = q / I_OUT, r = q % I_OUT, kb = r / 32, nb = r % 32;
                transpose_item(P.w_out + (size_t)l * D * D, D, D, (bf16*)(ws + WS_WOUT) + (size_t)l * D * D, 32 * nb, scr, 64 * kb, 32 * nb, F.lane); }
            else if (it < B3) { const int q = it - B2, second = q / I_F13, r = q % I_F13, kb = r / 88, nb = r % 88;
                transpose_item(second ? P.ffn_w3 : P.ffn_w1, D, DFF, (bf16*)(ws + WS_F13), swiglu_dst_row(32 * nb, second), scr, 64 * kb, 32 * nb, F.lane); }
            else if (it < B4) { const int r = it - B3, kb = r / 32, nb = r % 32;
                transpose_item(P.ffn_w2, DFF, D, (bf16*)(ws + WS_F2), 32 * nb, scr, 64 * kb, 32 * nb, F.lane); }
            else if (it < B5) { const int q = it - B4, me = q / I_M13, second = me >> 3, e = me & 7, r = q % I_M13, kb = r / 112, nb = r % 112;
                transpose_item_f8((second ? P.moe_w3 : P.moe_w1) + (size_t)e * D * DFE, D, DFE, ws + WS_MOE13 + (size_t)e * 2 * DFE * D, swiglu_dst_row(32 * nb, second), scr, 64 * kb, 32 * nb, F.lane, F8_W13); }
            else { const int q = it - B5, e = q / I_M2, r = q % I_M2, kb = r / 32, nb = r % 32;
                transpose_item_f8(P.moe_w2 + (size_t)e * DFE * D, DFE, D, ws + WS_MOE2 + (size_t)e * D * DFE, 32 * nb, scr, 64 * kb, 32 * nb, F.lane, F8_W2); }
        }
    }
}

template <bool OUT8>
__device__ __forceinline__ void norm_row(const float* xrow, const float* gain, const float* scp, const float* shp, bf16* orow, int lane, f32x4 (&hv)[4]) {
    const GAS f32x4* xr = (const GAS f32x4*)xrow + lane;
    f32x4 v[4]; float s = 0.f;
#pragma unroll
    for (int j = 0; j < 4; ++j) { v[j] = xr[64 * j]; s += (v[j].x * v[j].x + v[j].y * v[j].y) + (v[j].z * v[j].z + v[j].w * v[j].w); }
    const float rstd = 1.0f / sqrtf(wave_sum(s) * (1.0f / D) + EPS);
    GAS u32x2* o8 = (GAS u32x2*)orow + lane;
#pragma unroll
    for (int j = 0; j < 4; ++j) { const f32x4 g = *((const GAS f32x4*)gain + lane + 64 * j), sc = *((const GAS f32x4*)scp + lane + 64 * j), sh = *((const GAS f32x4*)shp + lane + 64 * j);
        const f32x4 o = (v[j] * rstd) * g * (sc + 1.0f) + sh; hv[j] = o;
        if constexpr (OUT8) { ((GAS unsigned*)orow)[lane + 64 * j] = pk4_fp8(o[0] * F8_H, o[1] * F8_H, o[2] * F8_H, o[3] * F8_H); }
        else { u32x2 w; w.x = cvt_pk_bf16(o[0], o[1]); w.y = cvt_pk_bf16(o[2], o[3]); o8[64 * j] = w; } }
}
__device__ __forceinline__ void norm_phase(const Frame& F, const float* xin, const float* gain, const float* modl, int ch_shift, int ch_scale, bf16* H) {
    const int gw = F.bid * NWAVES + F.wave, NGW = F.G * NWAVES;
    for (int m = gw; m < M; m += NGW) { const int b = m >> 11; f32x4 hv[4];
        norm_row<false>(xin + (size_t)m * D, gain, modl + (size_t)b * MODW + ch_scale * D, modl + (size_t)b * MODW + ch_shift * D, H + (size_t)m * D, F.lane, hv); }
}
__device__ __forceinline__ void norm_router_phase(const Frame& F, const float* xin, const float* gain, const float* modl, int ch_shift, int ch_scale, bf16* H,
                                                  const float* router, int* tok_e, float* tok_w, int* tok_slot, unsigned* cnt) {
    LAS float* RT = (LAS float*)(F.lds);
    LAS int* lcnt = (LAS int*)(F.lds + 32768);
    LAS int* basee = (LAS int*)(F.lds + 32768 + 64);
    LAS int* rinfo = (LAS int*)(F.lds + 32768 + 128);
    for (int i = F.tid; i < D * NE; i += NTHR) { const int k = i >> 3, e = i & 7; RT[e * D + k] = router[i]; }
    __syncthreads();
    for (int rb = F.bid; rb < M / 64; rb += F.G) {
        if (F.tid < 8) lcnt[F.tid] = 0;
        __syncthreads();
        for (int rr = 0; rr < 8; ++rr) {
            const int lr = F.wave * 8 + rr, m = rb * 64 + lr, b = m >> 11; f32x4 hv[4];
            norm_row<true>(xin + (size_t)m * D, gain, modl + (size_t)b * MODW + ch_scale * D, modl + (size_t)b * MODW + ch_shift * D, (bf16*)((unsigned char*)H + (size_t)m * D), F.lane, hv);
            float lg[8];
#pragma unroll
            for (int e = 0; e < 8; ++e) { float a = 0.f;
#pragma unroll
                for (int j = 0; j < 4; ++j) { const f32x4 r = *((const LAS f32x4*)(RT + e * D) + F.lane + 64 * j); a += (hv[j][0] * r[0] + hv[j][1] * r[1]) + (hv[j][2] * r[2] + hv[j][3] * r[3]); }
                lg[e] = wave_sum(a); }
            int e1 = 0; float v1 = lg[0];
#pragma unroll
            for (int e = 1; e < 8; ++e) if (lg[e] > v1) { v1 = lg[e]; e1 = e; }
            int e2 = -1; float v2 = -3.0e38f;
#pragma unroll
            for (int e = 0; e < 8; ++e) if (e != e1 && lg[e] > v2) { v2 = lg[e]; e2 = e; }
            if (F.lane == 0) {
                const float w1 = 1.0f / (1.0f + expf(v2 - v1));
                const int l1 = atomicAdd((int*)&lcnt[e1], 1), l2 = atomicAdd((int*)&lcnt[e2], 1);
                rinfo[lr * 4 + 0] = e1; rinfo[lr * 4 + 1] = l1; rinfo[lr * 4 + 2] = e2; rinfo[lr * 4 + 3] = l2;
                tok_e[2 * m] = e1; tok_e[2 * m + 1] = e2; tok_w[2 * m] = w1; tok_w[2 * m + 1] = 1.0f - w1;
            }
        }
        __syncthreads();
        if (F.tid < 8) basee[F.tid] = (int)__hip_atomic_fetch_add(cnt + 64 * F.tid, (unsigned)lcnt[F.tid], __ATOMIC_RELAXED, __HIP_MEMORY_SCOPE_AGENT);
        __syncthreads();
        if (F.tid < 64) { const int m = rb * 64 + F.tid; const int e1 = rinfo[F.tid * 4], l1 = rinfo[F.tid * 4 + 1], e2 = rinfo[F.tid * 4 + 2], l2 = rinfo[F.tid * 4 + 3];
            tok_slot[2 * m] = basee[e1] + l1; tok_slot[2 * m + 1] = basee[e2] + l2; }
        __syncthreads();
    }
}
__device__ __forceinline__ void map_phase(const Frame& F, const unsigned* cnt, const int* tok_e, const float* tok_w, const int* tok_slot, int* tok_dst, int* sorted_tok, float* slot_w) {
    int c[8], off[9]; off[0] = 0;
#pragma unroll
    for (int e = 0; e < 8; ++e) { c[e] = (int)cnt[64 * e]; off[e + 1] = off[e] + ((c[e] + 255) & ~255); }
    const int gt = F.bid * NTHR + F.tid, NT = F.G * NTHR;
    for (int i = gt; i < 2 * M; i += NT) { const int e = tok_e[i]; int o = 0;
#pragma unroll
        for (int k = 0; k < 8; ++k) o = (e == k) ? off[k] : o;
        const int dst = o + tok_slot[i]; tok_dst[i] = dst; sorted_tok[dst] = i >> 1; slot_w[dst] = tok_w[i]; }
    for (int i = gt; i < 8 * 256; i += NT) { const int e = i >> 8, r = i & 255; int o = 0, ce = 0, oe = 0;
#pragma unroll
        for (int k = 0; k < 8; ++k) { o = (e == k) ? off[k] : o; ce = (e == k) ? c[k] : ce; oe = (e == k) ? off[k + 1] : oe; }
        const int p = o + ce + r; if (p < oe) { sorted_tok[p] = 0; slot_w[p] = 0.f; } }
}
__device__ __forceinline__ void combine_phase(const Frame& F, float* x, const float* gate, const bf16* Y, const int* tok_dst) {
    const int gw = F.bid * NWAVES + F.wave, NGW = F.G * NWAVES;
    for (int m = gw; m < M; m += NGW) { const int b = m >> 11; const int d0 = tok_dst[2 * m], d1 = tok_dst[2 * m + 1];
        GAS f32x4* xr = (GAS f32x4*)(x + (size_t)m * D) + F.lane; const GAS u32x2* y0 = (const GAS u32x2*)(Y + (size_t)d0 * D) + F.lane; const GAS u32x2* y1 = (const GAS u32x2*)(Y + (size_t)d1 * D) + F.lane;
        const GAS f32x4* gp = (const GAS f32x4*)(gate + (size_t)b * MODW) + F.lane;
#pragma unroll
        for (int j = 0; j < 4; ++j) { const f32x4 xv = xr[64 * j], g = gp[64 * j]; const u32x2 a = y0[64 * j], bq = y1[64 * j];
            const f32x4 ys = (f32x4){bflo(a.x) + bflo(bq.x), bfhi(a.x) + bfhi(bq.x), bflo(a.y) + bflo(bq.y), bfhi(a.y) + bfhi(bq.y)};
            xr[64 * j] = xv + g * ys; }
    }
}


constexpr int MIXBUF = 65536, BROW_OFF = 132096;
constexpr int BROWX_OFF = BROW_OFF + 24 * 132 * 4;
static_assert(BROW_OFF >= MISC_OFF + 128 && BROWX_OFF + 2 * 384 * 4 <= LDS_BYTES, "bias rows");
typedef short v4i16_t __attribute__((ext_vector_type(4)));
#define GLDS16(gptr, ldsptr) __builtin_amdgcn_global_load_lds((const unsigned*)(gptr), (LAS unsigned*)(ldsptr), 16, 0, 0)
__device__ __forceinline__ v4i16_t tr_read(const LAS unsigned char* p) { return __builtin_amdgcn_ds_read_tr16_b64_v4i16((LAS v4i16_t*)p); }
__device__ __forceinline__ bf16x8 cat8(v4i16_t a, v4i16_t b) { return (bf16x8){a[0], a[1], a[2], a[3], b[0], b[1], b[2], b[3]}; }
__device__ __forceinline__ bf16x8 pack8(f32x4 a, f32x4 b) { u32x4 w; w.x = cvt_pk_bf16(a[0], a[1]); w.y = cvt_pk_bf16(a[2], a[3]); w.z = cvt_pk_bf16(b[0], b[1]); w.w = cvt_pk_bf16(b[2], b[3]); return __builtin_bit_cast(bf16x8, w); }
__device__ __forceinline__ int img128(int r, int c) { return r * 128 + ((c ^ (r & 7)) << 4); }
__device__ __forceinline__ int img256(int r, int c) { return r * 256 + ((c ^ ((r & 7) << 1)) << 4); }

struct AttnUnit { int p, d, b, h, r, n; };
__device__ __forceinline__ AttnUnit attn_unit(int u) {
    AttnUnit a; a.p = u >> 10; const int v = u & 1023, j = v & 15; a.b = v >> 7; a.h = (v >> 4) & 7;
    a.d = a.p == 0 ? 1 : (a.p == 1 ? 4 : 16);
    if (a.p == 0) { a.r = 0; a.n = j; } else if (a.p == 1) { a.r = j >> 2; a.n = j & 3; } else { a.r = j; a.n = 0; }
    return a;
}
__device__ __forceinline__ void attn_prefetch(const Frame& F, const AttnUnit& a, const bf16* Kg, const bf16* Vg, LAS unsigned char* buf, const LAS float* master, LAS float* browx) {
    if (F.tid < 384) { const int rel = F.tid - 128; const float mv = master[min(max(rel, 0), 128)]; browx[F.tid] = (rel >= 0 && rel <= 128) ? mv : -1.0e30f; }
    const int c = (F.lane & 7) ^ (F.lane >> 3);
#pragma unroll
    for (int it = 0; it < 4; ++it) {
        const int ii = F.wave + 8 * it;
        if (a.n > 0 || ii >= 16) {
            const int j = 8 * ii + (F.lane >> 3), t = (128 * (a.n - 1) + j) * a.d + a.r;
            const size_t off = ((size_t)(a.b * SEQ + t) * AW + a.h * HD + c * 8) * 2;
            GLDS16((const char*)Kg + off, buf + ii * 1024);
            GLDS16((const char*)Vg + off, buf + 32768 + ii * 1024);
        }
    }
}
template <int NT>
__device__ __forceinline__ void attn_compute(const Frame& F, int jlo, const LAS unsigned char* buf, const LAS float* brow, bf16x8 qf0, bf16x8 qf1, bf16* Orow, float* lsep) {
    const int w = F.wave, qi = F.lane & 15, g = F.lane >> 4;
    const LAS unsigned char* kb = buf; const LAS unsigned char* vb = buf + 32768;
#define SCHED_FENCE() __builtin_amdgcn_sched_barrier(0)
    bf16x8 kf[NT][2];
#pragma unroll
    for (int tt = 0; tt < NT; ++tt) { const int key = 16 * (jlo + tt) + qi; kf[tt][0] = *(const LAS bf16x8*)(kb + img128(key, g)); kf[tt][1] = *(const LAS bf16x8*)(kb + img128(key, g + 4)); }
    SCHED_FENCE();
    f32x4 s[NT];
#pragma unroll
    for (int tt = 0; tt < NT; ++tt) { const f32x4 acc = __builtin_amdgcn_mfma_f32_16x16x32_bf16(kf[tt][0], qf0, (f32x4){0.f, 0.f, 0.f, 0.f}, 0, 0, 0);
        s[tt] = __builtin_amdgcn_mfma_f32_16x16x32_bf16(kf[tt][1], qf1, acc, 0, 0, 0); }
    v4i16_t vf[NT / 2][4][2];
    const int sub = (qi & 1) * 8, cb = (qi >> 1) & 1;
#pragma unroll
    for (int cc = 0; cc < NT / 2; ++cc) { const int row = 16 * (jlo + 2 * cc) + 4 * g + (qi >> 2);
#pragma unroll
        for (int dt = 0; dt < 4; ++dt) { vf[cc][dt][0] = tr_read(vb + img128(row, 2 * dt + cb) + sub); vf[cc][dt][1] = tr_read(vb + img128(row + 16, 2 * dt + cb) + sub); } }
    const int i = 16 * w + qi; float bv[NT][4];
#pragma unroll
    for (int tt = 0; tt < NT; ++tt) {
#pragma unroll
        for (int rg = 0; rg < 4; ++rg) bv[tt][rg] = brow[i - (16 * (jlo + tt) + 4 * g + rg) + 256]; }
    SCHED_FENCE();
    float mx = -1.0e30f;
#pragma unroll
    for (int tt = 0; tt < NT; ++tt) {
#pragma unroll
        for (int rg = 0; rg < 4; ++rg) { const float v = s[tt][rg] + bv[tt][rg]; s[tt][rg] = v; mx = fmaxf(mx, v); } }
    mx = fmaxf(mx, __shfl_xor(mx, 16)); mx = fmaxf(mx, __shfl_xor(mx, 32));
    float sum = 0.f;
#pragma unroll
    for (int tt = 0; tt < NT; ++tt) {
#pragma unroll
        for (int rg = 0; rg < 4; ++rg) { const float pz = __builtin_amdgcn_exp2f((s[tt][rg] - mx) * 1.4426950408889634f); s[tt][rg] = pz; sum += pz; } }
    sum += __shfl_xor(sum, 16); sum += __shfl_xor(sum, 32);
    f32x4 o[4];
#pragma unroll
    for (int dt = 0; dt < 4; ++dt) o[dt] = (f32x4){0.f, 0.f, 0.f, 0.f};
#pragma unroll
    for (int cc = 0; cc < NT / 2; ++cc) { const bf16x8 pf = pack8(s[2 * cc], s[2 * cc + 1]);
#pragma unroll
        for (int dt = 0; dt < 4; ++dt) o[dt] = __builtin_amdgcn_mfma_f32_16x16x32_bf16(cat8(vf[cc][dt][0], vf[cc][dt][1]), pf, o[dt], 0, 0, 0); }
    const float inv = __builtin_amdgcn_rcpf(sum);
#pragma unroll
    for (int dt = 0; dt < 4; ++dt) { u32x2 wv; wv.x = cvt_pk_bf16(o[dt][0] * inv, o[dt][1] * inv); wv.y = cvt_pk_bf16(o[dt][2] * inv, o[dt][3] * inv); *(u32x2*)(Orow + 16 * dt + 4 * g) = wv; }
    if (g == 0) *lsep = mx + __logf(sum);
}
__device__ __forceinline__ void attn_phase(const Frame& F, unsigned char* ws, const float* bias_tab) {
    const bf16* Qg = (const bf16*)(ws + WS_Q); const bf16* Kg = (const bf16*)(ws + WS_K); const bf16* Vg = (const bf16*)(ws + WS_V);
    const int NU = 3 * 1024, nr = (NU + F.G - 1) / F.G;
    LAS float* brow = (LAS float*)(F.lds + BROW_OFF);
    LAS float* browx = (LAS float*)(F.lds + BROWX_OFF);
    for (int r = F.tid; r < 24 * 132; r += NTHR) { const int ph = r / 132, rel = r - ph * 132; if (rel <= 128) brow[r] = bias_tab[(int)T5_BUCKET[ph >> 3][rel] * NHEAD + (ph & 7)]; }
    __syncthreads();
    int u = F.bid; AttnUnit cur = attn_unit(u < NU ? u : 0); bool have = u < NU;
    const int qi = F.lane & 15, g = F.lane >> 4;
    bf16x8 qf0 = (bf16x8){0, 0, 0, 0, 0, 0, 0, 0}, qf1 = qf0; size_t qrow = 0;
    if (have) { attn_prefetch(F, cur, Kg, Vg, F.lds, brow + (cur.p * 8 + cur.h) * 132, browx);
        qrow = (size_t)(cur.b * SEQ + (128 * cur.n + 16 * F.wave + qi) * cur.d + cur.r); const bf16* qp = Qg + qrow * AW + cur.h * HD + 8 * g; qf0 = *(const bf16x8*)qp; qf1 = *(const bf16x8*)(qp + 32); }
    for (int k = 0; k < nr; ++k) {
        const int un = (k + 1) * F.G + (int)((unsigned)(F.bid + 37 * (k + 1)) % (unsigned)F.G); const bool hn = (k + 1 < nr) && un < NU; const AttnUnit nxt = attn_unit(hn ? un : 0);
        asm volatile("s_waitcnt vmcnt(0) lgkmcnt(0)" ::: "memory"); __syncthreads();
        bf16x8 nq0 = qf0, nq1 = qf1; size_t nqrow = 0;
        if (hn) { attn_prefetch(F, nxt, Kg, Vg, F.lds + ((k + 1) & 1) * MIXBUF, brow + (nxt.p * 8 + nxt.h) * 132, browx + ((k + 1) & 1) * 384);
            nqrow = (size_t)(nxt.b * SEQ + (128 * nxt.n + 16 * F.wave + qi) * nxt.d + nxt.r); const bf16* qp = Qg + nqrow * AW + nxt.h * HD + 8 * g; nq0 = *(const bf16x8*)qp; nq1 = *(const bf16x8*)(qp + 32); }
        if (have) { bf16* Orow = (bf16*)(ws + WS_ATTO) + (size_t)cur.p * M * AW + qrow * AW + cur.h * HD; float* lsep = (float*)(ws + WS_LSE) + (size_t)cur.p * M * NHEAD + qrow * NHEAD + cur.h;
            if (cur.n > 0) attn_compute<10>(F, 2 * (F.wave >> 1), F.lds + (k & 1) * MIXBUF, browx + (k & 1) * 384, qf0, qf1, Orow, lsep);
            else attn_compute<8>(F, 8, F.lds + (k & 1) * MIXBUF, browx + (k & 1) * 384, qf0, qf1, Orow, lsep); }
        cur = nxt; have = hn; qf0 = nq0; qf1 = nq1; qrow = nqrow;
    }
    asm volatile("s_waitcnt vmcnt(0) lgkmcnt(0)" ::: "memory"); __syncthreads();
}

__device__ __forceinline__ void ret_prefetch(const Frame& F, int unit, const bf16* RKg, const bf16* RVg, const bf16* STg, LAS unsigned char* buf) {
    const int b = unit >> 6, h = (unit >> 4) & 3, i = unit & 15; const size_t row0 = (size_t)b * SEQ + 128 * i;
    { const int c = (F.lane & 7) ^ (F.lane >> 3);
#pragma unroll
      for (int it = 0; it < 2; ++it) { const int ii = F.wave + 8 * it, pos = 8 * ii + (F.lane >> 3);
          GLDS16((const char*)RKg + ((row0 + pos) * 256 + h * RDK + c * 8) * 2, buf + ii * 1024);
          if (STg != nullptr && i > 0) GLDS16((const char*)STg + (((size_t)unit * RDV + pos) * RDK + c * 8) * 2, buf + 49152 + ii * 1024); } }
#pragma unroll
    for (int it = 0; it < 4; ++it) { const int ii = F.wave + 8 * it, pos = 4 * ii + (F.lane >> 4), c = (F.lane & 15) ^ ((pos & 7) << 1);
        GLDS16((const char*)RVg + ((row0 + pos) * 512 + h * RDV + c * 8) * 2, buf + 16384 + ii * 1024); }
}
__device__ __forceinline__ void ret_kv_compute(const Frame& F, int unit, const LAS unsigned char* buf, float* KVT) {
    const int w = F.wave, qi = F.lane & 15, g = F.lane >> 4;
    const LAS unsigned char* kb = buf; const LAS unsigned char* vb = buf + 16384;
    f32x4 acc[4];
#pragma unroll
    for (int a = 0; a < 4; ++a) acc[a] = (f32x4){0.f, 0.f, 0.f, 0.f};
    const int sub = (qi & 1) * 8;
#pragma unroll
    for (int ch = 0; ch < 4; ++ch) { const int row = 32 * ch + 4 * g + (qi >> 2);
        const int cv = 2 * w + ((qi >> 1) & 1);
        const bf16x8 bfr = cat8(tr_read(vb + img256(row, cv) + sub), tr_read(vb + img256(row + 16, cv) + sub));
#pragma unroll
        for (int a = 0; a < 4; ++a) { const int ck = 2 * a + ((qi >> 1) & 1);
            const bf16x8 afr = cat8(tr_read(kb + img128(row, ck) + sub), tr_read(kb + img128(row + 16, ck) + sub));
            acc[a] = __builtin_amdgcn_mfma_f32_16x16x32_bf16(afr, bfr, acc[a], 0, 0, 0); } }
    float* dst = KVT + ((size_t)unit * RDV + 16 * w + qi) * RDK + 4 * g;
#pragma unroll
    for (int a = 0; a < 4; ++a) *(f32x4*)(dst + 16 * a) = acc[a];
}
__device__ __forceinline__ void ret_kv_phase(const Frame& F, unsigned char* ws) {
    const bf16* RKg = (const bf16*)(ws + WS_RK); const bf16* RVg = (const bf16*)(ws + WS_RV); float* KVT = (float*)(ws + WS_KVST);
    const int NU = BATCH * RH * 16, nr = (NU + F.G - 1) / F.G;
    int u = F.bid; bool have = u < NU;
    if (have) ret_prefetch(F, u, RKg, RVg, nullptr, F.lds);
    for (int k = 0; k < nr; ++k) {
        const int un = (k + 1) * F.G + F.bid; const bool hn = (k + 1 < nr) && un < NU;
        asm volatile("s_waitcnt vmcnt(0) lgkmcnt(0)" ::: "memory"); __syncthreads();
        if (hn) ret_prefetch(F, un, RKg, RVg, nullptr, F.lds + ((k + 1) & 1) * MIXBUF);
        if (have) ret_kv_compute(F, u, F.lds + (k & 1) * MIXBUF, KVT);
        u = un; have = hn;
    }
    asm volatile("s_waitcnt vmcnt(0) lgkmcnt(0)" ::: "memory"); __syncthreads();
}
__device__ __forceinline__ void ret_out_compute(const Frame& F, int unit, const LAS unsigned char* buf, bf16x8 qf0, bf16x8 qf1, const bf16* RGg, const float* ret_gain, bf16* MIX) {
    const int w = F.wave, qi = F.lane & 15, g = F.lane >> 4;
    const int b = unit >> 6, h = (unit >> 4) & 3, i = unit & 15; const size_t row = (size_t)b * SEQ + 128 * i + 16 * w + qi;
    const LAS unsigned char* kb = buf; const LAS unsigned char* vb = buf + 16384; const LAS unsigned char* sb = buf + 49152;
    f32x4 s[8];
#pragma unroll
    for (int tt = 0; tt < 8; ++tt) { const int key = 16 * tt + qi;
        const bf16x8 a0 = *(const LAS bf16x8*)(kb + img128(key, g)), a1 = *(const LAS bf16x8*)(kb + img128(key, g + 4));
        f32x4 acc = __builtin_amdgcn_mfma_f32_16x16x32_bf16(a0, qf0, (f32x4){0.f, 0.f, 0.f, 0.f}, 0, 0, 0);
        acc = __builtin_amdgcn_mfma_f32_16x16x32_bf16(a1, qf1, acc, 0, 0, 0);
#pragma unroll
        for (int rg = 0; rg < 4; ++rg) acc[rg] = (16 * tt + 4 * g + rg <= 16 * w + qi) ? acc[rg] : 0.f;
        s[tt] = acc; }
    f32x4 o[8];
#pragma unroll
    for (int dt = 0; dt < 8; ++dt) o[dt] = (f32x4){0.f, 0.f, 0.f, 0.f};
    const int sub = (qi & 1) * 8;
#pragma unroll
    for (int cc = 0; cc < 4; ++cc) {
        const bf16x8 pf = pack8(s[2 * cc], s[2 * cc + 1]); const int r0 = 32 * cc + 4 * g + (qi >> 2);
#pragma unroll
        for (int dt = 0; dt < 8; ++dt) { const int cv = 2 * dt + ((qi >> 1) & 1);
            o[dt] = __builtin_amdgcn_mfma_f32_16x16x32_bf16(cat8(tr_read(vb + img256(r0, cv) + sub), tr_read(vb + img256(r0 + 16, cv) + sub)), pf, o[dt], 0, 0, 0); }
    }
    if (i > 0) {
#pragma unroll
        for (int dt = 0; dt < 8; ++dt) { const int dv = 16 * dt + qi;
            const bf16x8 s0 = *(const LAS bf16x8*)(sb + img128(dv, g)), s1 = *(const LAS bf16x8*)(sb + img128(dv, g + 4));
            o[dt] = __builtin_amdgcn_mfma_f32_16x16x32_bf16(s0, qf0, o[dt], 0, 0, 0); o[dt] = __builtin_amdgcn_mfma_f32_16x16x32_bf16(s1, qf1, o[dt], 0, 0, 0); }
    }
    float sm = 0.f;
#pragma unroll
    for (int dt = 0; dt < 8; ++dt) sm += (o[dt][0] + o[dt][1]) + (o[dt][2] + o[dt][3]);
    sm += __shfl_xor(sm, 16); sm += __shfl_xor(sm, 32);
    const float mu = sm * (1.0f / RDV); float sq = 0.f;
#pragma unroll
    for (int dt = 0; dt < 8; ++dt) { o[dt] = o[dt] - mu; sq += (o[dt][0] * o[dt][0] + o[dt][1] * o[dt][1]) + (o[dt][2] * o[dt][2] + o[dt][3] * o[dt][3]); }
    sq += __shfl_xor(sq, 16); sq += __shfl_xor(sq, 32);
    const float rstd = 1.0f / sqrtf(sq * (1.0f / RDV) + EPS);
#pragma unroll
    for (int dt = 0; dt < 8; ++dt) { const int dv = h * RDV + 16 * dt + 4 * g;
        const f32x4 gn = *(const f32x4*)(ret_gain + dv); const u32x2 gw = *(const u32x2*)(RGg + row * 512 + dv);
        const f32x4 gt = (f32x4){bflo(gw.x), bfhi(gw.x), bflo(gw.y), bfhi(gw.y)};
        const f32x4 y = o[dt] * rstd * gn * silu4(gt);
        u32x2 wv; wv.x = cvt_pk_bf16(y[0], y[1]); wv.y = cvt_pk_bf16(y[2], y[3]); *(u32x2*)(MIX + row * D + AW + dv) = wv; }
}
__device__ __forceinline__ void ret_out_phase(const Frame& F, unsigned char* ws, const float* ret_gain) {
    const bf16* RQg = (const bf16*)(ws + WS_RQ); const bf16* RKg = (const bf16*)(ws + WS_RK); const bf16* RVg = (const bf16*)(ws + WS_RV); const bf16* RGg = (const bf16*)(ws + WS_RG);
    const bf16* STg = (const bf16*)(ws + WS_STATE); bf16* MIX = (bf16*)(ws + WS_MIXED);
    const int NU = BATCH * RH * 16, nr = (NU + F.G - 1) / F.G;
    int u = F.bid; bool have = u < NU;
    if (have) ret_prefetch(F, u, RKg, RVg, STg, F.lds);
    for (int k = 0; k < nr; ++k) {
        const int un = (k + 1) * F.G + F.bid; const bool hn = (k + 1 < nr) && un < NU;
        bf16x8 qf0 = (bf16x8){0, 0, 0, 0, 0, 0, 0, 0}, qf1 = qf0;
        if (have) { const int qi = F.lane & 15, g = F.lane >> 4, b = u >> 6, h = (u >> 4) & 3, i = u & 15;
            const bf16* qp = RQg + ((size_t)b * SEQ + 128 * i + 16 * F.wave + qi) * 256 + h * RDK + 8 * g; qf0 = *(const bf16x8*)qp; qf1 = *(const bf16x8*)(qp + 32); }
        asm volatile("s_waitcnt vmcnt(0) lgkmcnt(0)" ::: "memory"); __syncthreads();
        if (hn) ret_prefetch(F, un, RKg, RVg, STg, F.lds + ((k + 1) & 1) * MIXBUF);
        if (have) ret_out_compute(F, u, F.lds + (k & 1) * MIXBUF, qf0, qf1, RGg, ret_gain, MIX);
        u = un; have = hn;
    }
    asm volatile("s_waitcnt vmcnt(0) lgkmcnt(0)" ::: "memory"); __syncthreads();
}
__device__ __forceinline__ void ret_state_phase(const Frame& F, unsigned char* ws) {
    const float* KVT = (const float*)(ws + WS_KVST); bf16* STg = (bf16*)(ws + WS_STATE);
    for (int it = F.bid; it < BATCH * RH * 8; it += F.G) {
        const int bh = it >> 3, sl = it & 7, h = bh & 3;
        if (F.tid < 256) {
            const int dv = 16 * sl + (F.tid >> 4), c4 = F.tid & 15; const float G = __builtin_amdgcn_exp2f(128.0f * ret_lg(h));
            f32x4 kv[15];
#pragma unroll
            for (int j = 0; j < 15; ++j) kv[j] = *(const f32x4*)(KVT + ((size_t)(bh * 16 + j) * RDV + dv) * RDK + 4 * c4);
            f32x4 st = (f32x4){0.f, 0.f, 0.f, 0.f};
#pragma unroll
            for (int j = 0; j < 15; ++j) { st = (st + kv[j]) * G; u32x2 wv; wv.x = cvt_pk_bf16(st[0], st[1]); wv.y = cvt_pk_bf16(st[2], st[3]);
                *(u32x2*)(STg + ((size_t)(bh * 16 + j + 1) * RDV + dv) * RDK + 4 * c4) = wv; }
        }
    }
}
__device__ __forceinline__ void merge_phase(const Frame& F, unsigned char* ws) {
    const bf16* AO = (const bf16*)(ws + WS_ATTO); const float* LS = (const float*)(ws + WS_LSE); bf16* MIX = (bf16*)(ws + WS_MIXED);
    for (int idx = F.bid * NTHR + F.tid; idx < M * NHEAD * 8; idx += F.G * NTHR) {
        const int row = idx >> 6, head = (idx >> 3) & 7, c = idx & 7;
        const float l0 = LS[(size_t)row * NHEAD + head], l1 = LS[(size_t)M * NHEAD + (size_t)row * NHEAD + head], l2 = LS[(size_t)2 * M * NHEAD + (size_t)row * NHEAD + head];
        const float mx = fmaxf(l0, fmaxf(l1, l2)); const float e0 = __expf(l0 - mx), e1 = __expf(l1 - mx), e2 = __expf(l2 - mx), inv = 1.0f / (e0 + e1 + e2);
        const size_t off = (size_t)row * AW + head * HD + c * 8;
        const u32x4 a = *(const u32x4*)(AO + off), bq = *(const u32x4*)(AO + (size_t)M * AW + off), cq = *(const u32x4*)(AO + (size_t)2 * M * AW + off);
        const float w0 = e0 * inv, w1 = e1 * inv, w2 = e2 * inv;
        u32x4 o;
        o.x = cvt_pk_bf16(w0 * bflo(a.x) + w1 * bflo(bq.x) + w2 * bflo(cq.x), w0 * bfhi(a.x) + w1 * bfhi(bq.x) + w2 * bfhi(cq.x));
        o.y = cvt_pk_bf16(w0 * bflo(a.y) + w1 * bflo(bq.y) + w2 * bflo(cq.y), w0 * bfhi(a.y) + w1 * bfhi(bq.y) + w2 * bfhi(cq.y));
        o.z = cvt_pk_bf16(w0 * bflo(a.z) + w1 * bflo(bq.z) + w2 * bflo(cq.z), w0 * bfhi(a.z) + w1 * bfhi(bq.z) + w2 * bfhi(cq.z));
        o.w = cvt_pk_bf16(w0 * bflo(a.w) + w1 * bflo(bq.w) + w2 * bflo(cq.w), w0 * bfhi(a.w) + w1 * bfhi(bq.w) + w2 * bfhi(cq.w));
        *(u32x4*)(MIX + (size_t)row * D + head * HD + c * 8) = o;
    }
}

__global__ void __launch_bounds__(256) naive_attn(const bf16* __restrict__ Q, const bf16* __restrict__ Kb, const bf16* __restrict__ V, const float* __restrict__ bias_tab, bf16* __restrict__ MIX) {
    const int idx = blockIdx.x * 256 + threadIdx.x, head = idx & 7, tok = idx >> 3, b = tok >> 11, t = tok & (SEQ - 1);
    float q[64], acc[64];
    { const u32x4* qp = (const u32x4*)(Q + (size_t)tok * AW + head * 64);
#pragma unroll
      for (int i = 0; i < 8; ++i) { const u32x4 w = qp[i]; q[8 * i] = bflo(w.x); q[8 * i + 1] = bfhi(w.x); q[8 * i + 2] = bflo(w.y); q[8 * i + 3] = bfhi(w.y); q[8 * i + 4] = bflo(w.z); q[8 * i + 5] = bfhi(w.z); q[8 * i + 6] = bflo(w.w); q[8 * i + 7] = bfhi(w.w); } }
#pragma unroll
    for (int i = 0; i < 64; ++i) acc[i] = 0.f;
    float mx = -3.0e38f, l = 0.f;
    for (int br = 0; br < 3; ++br) { const int d = br == 0 ? 1 : (br == 1 ? 4 : 16);
        for (int dl = 0; dl <= 128; ++dl) { const int tk = t - dl * d; if (tk < 0) break;
            const size_t ro = (size_t)(b * SEQ + tk) * AW + head * 64; const u32x4* kp = (const u32x4*)(Kb + ro); const u32x4* vp = (const u32x4*)(V + ro);
            float s = 0.f;
#pragma unroll
            for (int i = 0; i < 8; ++i) { const u32x4 w = kp[i]; s += q[8 * i] * bflo(w.x) + q[8 * i + 1] * bfhi(w.x) + q[8 * i + 2] * bflo(w.y) + q[8 * i + 3] * bfhi(w.y) + q[8 * i + 4] * bflo(w.z) + q[8 * i + 5] * bfhi(w.z) + q[8 * i + 6] * bflo(w.w) + q[8 * i + 7] * bfhi(w.w); }
            s += bias_tab[(int)T5_BUCKET[br][dl] * NHEAD + head];
            if (s > mx) { const float sc = expf(mx - s); l *= sc;
#pragma unroll
                for (int i = 0; i < 64; ++i) acc[i] *= sc;
                mx = s; }
            const float p = expf(s - mx); l += p;
#pragma unroll
            for (int i = 0; i < 8; ++i) { const u32x4 w = vp[i]; acc[8 * i] += p * bflo(w.x); acc[8 * i + 1] += p * bfhi(w.x); acc[8 * i + 2] += p * bflo(w.y); acc[8 * i + 3] += p * bfhi(w.y); acc[8 * i + 4] += p * bflo(w.z); acc[8 * i + 5] += p * bfhi(w.z); acc[8 * i + 6] += p * bflo(w.w); acc[8 * i + 7] += p * bfhi(w.w); }
        } }
    const float il = 1.0f / l; u32x4* op = (u32x4*)(MIX + (size_t)tok * D + head * 64);
#pragma unroll
    for (int i = 0; i < 8; ++i) { u32x4 w; w.x = cvt_pk_bf16(acc[8 * i] * il, acc[8 * i + 1] * il); w.y = cvt_pk_bf16(acc[8 * i + 2] * il, acc[8 * i + 3] * il); w.z = cvt_pk_bf16(acc[8 * i + 4] * il, acc[8 * i + 5] * il); w.w = cvt_pk_bf16(acc[8 * i + 6] * il, acc[8 * i + 7] * il); op[i] = w; }
}
__global__ void __launch_bounds__(128) naive_ret(const bf16* __restrict__ RQ, const bf16* __restrict__ RK, const bf16* __restrict__ RV, const bf16* __restrict__ RG, const float* __restrict__ ret_gain, bf16* __restrict__ MIX) {
    __shared__ float sred[4];
    const int bh = blockIdx.x, b = bh >> 2, h = bh & 3, dv = threadIdx.x, wv = dv >> 6;
    float st[64];
#pragma unroll
    for (int i = 0; i < 64; ++i) st[i] = 0.f;
    const float g128 = __builtin_amdgcn_exp2f(128.0f * ret_lg(h)), gn = ret_gain[h * RDV + dv];
    for (int t = 0; t < SEQ; ++t) { const size_t row = (size_t)b * SEQ + t;
        if ((t & 127) == 0 && t) {
#pragma unroll
            for (int i = 0; i < 64; ++i) st[i] *= g128; }
        const u32x4* kp = (const u32x4*)(RK + row * 256 + h * 64); const u32x4* qp = (const u32x4*)(RQ + row * 256 + h * 64);
        const float v = bf2f(RV[row * 512 + h * RDV + dv]), gt = bf2f(RG[row * 512 + h * RDV + dv]);
        float y = 0.f;
#pragma unroll
        for (int i = 0; i < 8; ++i) { const u32x4 kw = kp[i], qw = qp[i];
            st[8 * i] += bflo(kw.x) * v; y += bflo(qw.x) * st[8 * i]; st[8 * i + 1] += bfhi(kw.x) * v; y += bfhi(qw.x) * st[8 * i + 1];
            st[8 * i + 2] += bflo(kw.y) * v; y += bflo(qw.y) * st[8 * i + 2]; st[8 * i + 3] += bfhi(kw.y) * v; y += bfhi(qw.y) * st[8 * i + 3];
            st[8 * i + 4] += bflo(kw.z) * v; y += bflo(qw.z) * st[8 * i + 4]; st[8 * i + 5] += bfhi(kw.z) * v; y += bfhi(qw.z) * st[8 * i + 5];
            st[8 * i + 6] += bflo(kw.w) * v; y += bflo(qw.w) * st[8 * i + 6]; st[8 * i + 7] += bfhi(kw.w) * v; y += bfhi(qw.w) * st[8 * i + 7]; }
        float s1 = wave_sum(y); if ((dv & 63) == 0) sred[wv] = s1; __syncthreads(); const float mu = (sred[0] + sred[1]) * (1.0f / RDV);
        const float dd = y - mu; float s2 = wave_sum(dd * dd); if ((dv & 63) == 0) sred[2 + wv] = s2; __syncthreads(); const float var = (sred[2] + sred[3]) * (1.0f / RDV);
        const float o = dd * (1.0f / sqrtf(var + EPS)) * gn * silu_f(gt);
        MIX[row * D + AW + h * RDV + dv] = (bf16)f2bf(o);
        __syncthreads();
    }
}

#ifndef SITE_MASK
#define SITE_MASK 63
#endif
constexpr int PH_PRO = 0, PH_PER_LAYER = 11, NPH = 1 + 2 * PH_PER_LAYER;
struct Args { const float* in[19]; float* out; unsigned char* ws; int ph_lo, ph_hi, li, pad; };
__global__ void __launch_bounds__(NTHR, 2) fwd(Args args) {
    extern __shared__ __attribute__((aligned(16))) unsigned char lds[];
    Frame F; F.lds = (LAS unsigned char*)lds; F.tid = threadIdx.x; F.lane = F.tid & 63; F.wave = __builtin_amdgcn_readfirstlane(F.tid >> 6); F.G = gridDim.x; F.bid = blockIdx.x;
    volatile LAS unsigned* MISC = (volatile LAS unsigned*)(F.lds + MISC_OFF);
    Ptrs P; P.x = args.in[0]; P.c = args.in[1]; P.bias_tab = args.in[2]; P.norm_mix = args.in[3]; P.norm_ffn = args.in[4]; P.w_mod = args.in[5]; P.b_mod = args.in[6]; P.w_in = args.in[7];
    P.q_gain = args.in[8]; P.k_gain = args.in[9]; P.ret_gain = args.in[10]; P.w_out = args.in[11]; P.ffn_w1 = args.in[12]; P.ffn_w3 = args.in[13]; P.ffn_w2 = args.in[14]; P.router = args.in[15];
    P.moe_w1 = args.in[16]; P.moe_w3 = args.in[17]; P.moe_w2 = args.in[18]; P.out = args.out; P.ws = args.ws;
    unsigned char* ws = args.ws; gu32* ctl = (gu32*)(ws + WS_CTL);
    for (int u = F.tid; u < (LDS_BYTES - LDSCTL_OFF) / 4; u += NTHR) ((LAS unsigned*)(F.lds + LDSCTL_OFF))[u] = 0u;
    __syncthreads();
    XcdBarrier bar = xcd_barrier_post((unsigned*)(ctl + CW_BAR) + args.li * XCD_BAR_WORDS, MISC + 8);
    const int lo = args.ph_lo, hi = args.ph_hi;
#define IN(k) (lo <= (k) && (k) < hi)
#define SEAM(k) do { if (IN(k) && (k) + 1 < hi) xcd_barrier(bar); } while (0)
#ifndef REPEAT_MASK
#define REPEAT_MASK 0ull
#endif
#define REP(k) for (int rep_ = 0; rep_ <= (int)(((REPEAT_MASK) >> (k)) & 1ull); ++rep_)

    if (IN(PH_PRO)) REP(PH_PRO) { p0_prologue(phase_frame(F), P); } SEAM(PH_PRO);

    float* MOD = (float*)(ws + WS_MOD);
    for (int l = 0; l < 2; ++l) {
        const int pb = 1 + l * PH_PER_LAYER;
        const float* modl = MOD + (size_t)l * BATCH * MODW;
        const float* xin = l == 0 ? P.x : (const float*)P.out;
        if (IN(pb + 0)) REP(pb + 0) norm_phase(phase_frame(F), xin, P.norm_mix + l * D, modl, 0, 1, (bf16*)(ws + WS_H));
        SEAM(pb + 0);
        if (IN(pb + 1)) REP(pb + 1) {
            pg8::Gemm g{(const bf16*)(ws + WS_H), (const bf16*)(ws + WS_WIN) + (size_t)l * NIN * D, M, NIN, D, nullptr}; pg8::StaticOrder S; S.init(M, NIN, F.G, F.bid);
            EpiInProj E{ws, P.q_gain + l * HD, P.k_gain + l * HD};

#if SITE_MASK & 1
pg8::gemm_phase<EpiInProj, pg8::StaticOrder, false>(F.lds + RING_OFF, g, S, E);
#endif

        }
        SEAM(pb + 1);
        if (IN(pb + 2)) REP(pb + 2) { ret_kv_phase(phase_frame(F), ws); attn_phase(phase_frame(F), ws, P.bias_tab); }
        SEAM(pb + 2);
        if (IN(pb + 3)) REP(pb + 3) { ret_state_phase(phase_frame(F), ws); merge_phase(phase_frame(F), ws); }
        SEAM(pb + 3);
        if (IN(pb + 4)) REP(pb + 4) { ret_out_phase(phase_frame(F), ws, P.ret_gain + l * AW); }
        SEAM(pb + 4);
        if (IN(pb + 5)) {
            pg8::Gemm g{(const bf16*)(ws + WS_MIXED), (const bf16*)(ws + WS_WOUT) + (size_t)l * D * D, M, D, D, nullptr}; pg8::StaticOrder S; S.init(M, D, F.G, F.bid);
            EpiResid E{xin, P.out, modl + 2 * D};

#if SITE_MASK & 2
pg8::gemm_phase<EpiResid, pg8::StaticOrder, false>(F.lds + RING_OFF, g, S, E);
#endif

        }
        SEAM(pb + 5);
        if (IN(pb + 6)) {
            if (l == 0) norm_phase(phase_frame(F), P.out, P.norm_ffn + l * D, modl, 3, 4, (bf16*)(ws + WS_H));
            else norm_router_phase(phase_frame(F), P.out, P.norm_ffn + l * D, modl, 3, 4, (bf16*)(ws + WS_H), P.router, (int*)(ws + TOK_E), (float*)(ws + TOK_W), (int*)(ws + TOK_SLOT), (unsigned*)(ctl + CW_CNT));
        }
        SEAM(pb + 6);
        if (l == 1) {
            if (IN(pb + 7)) map_phase(phase_frame(F), (const unsigned*)(ctl + CW_CNT), (const int*)(ws + TOK_E), (const float*)(ws + TOK_W), (const int*)(ws + TOK_SLOT), (int*)(ws + TOK_DST), (int*)(ws + SORTED_TOK), (float*)(ws + SLOT_W));
            SEAM(pb + 7);
        }
        if (IN(pb + 8)) REP(pb + 8) {
            if (l == 0) {
                pg8::Gemm g{(const bf16*)(ws + WS_H), (const bf16*)(ws + WS_F13), M, 2 * DFF, D, nullptr}; pg8::StaticOrder S; S.init(M, 2 * DFF, F.G, F.bid);
                EpiSwiglu E{(bf16*)(ws + WS_HID), DFF, 2 * DFF / 256};

#if SITE_MASK & 4
pg8::gemm_phase<EpiSwiglu, pg8::StaticOrder, false>(F.lds + RING_OFF, g, S, E);
#endif

            } else {
                pg8::Gemm g{(const bf16*)(ws + WS_H), (const bf16*)(ws + WS_MOE13), MAXSLOT, 2 * DFE, D, (const int*)(ws + SORTED_TOK)}; MoeOrder S; S.init((const unsigned*)(ctl + CW_CNT), 2 * DFE / 256, F.G, F.bid);
                EpiSwigluF8 E{ws + WS_HID, DFE, 2 * DFE / 256};

#if SITE_MASK & 8
pg8::gemm_phase_f8<EpiSwigluF8, MoeOrder, true>(F.lds + RING_OFF, g, S, E);
#endif

            }
        }
        SEAM(pb + 8);
        if (IN(pb + 9)) REP(pb + 9) {
            if (l == 0) {
                pg8::Gemm g{(const bf16*)(ws + WS_HID), (const bf16*)(ws + WS_F2), M, D, DFF, nullptr}; pg8::StaticOrder S; S.init(M, D, F.G, F.bid);
                EpiResid E{P.out, P.out, modl + 5 * D};

#if SITE_MASK & 16
pg8::gemm_phase<EpiResid, pg8::StaticOrder, false>(F.lds + RING_OFF, g, S, E);
#endif

            } else {
                pg8::Gemm g{(const bf16*)(ws + WS_HID), (const bf16*)(ws + WS_MOE2), MAXSLOT, D, DFE, nullptr}; MoeOrder S; S.init((const unsigned*)(ctl + CW_CNT), D / 256, F.G, F.bid);
                EpiMoe2 E{(bf16*)(ws + WS_Y), (const float*)(ws + SLOT_W)};

#if SITE_MASK & 32
pg8::gemm_phase_f8<EpiMoe2, MoeOrder, false>(F.lds + RING_OFF, g, S, E);
#endif

            }
        }
        if (l == 1) {
            SEAM(pb + 9);
            if (IN(pb + 10)) combine_phase(phase_frame(F), P.out, modl + 5 * D, (const bf16*)(ws + WS_Y), (const int*)(ws + TOK_DST));
        } else { SEAM(pb + 9); }
    }
#undef IN
#undef SEAM
}

extern "C" void kernel_launch(void* const* d_in, const int* in_sizes, int n_in, void* d_out, int out_size, void* d_ws, size_t ws_size, hipStream_t stream) {
    static int grid = 0;
    if (grid == 0) {
        if (n_in != 19 || in_sizes[0] != M * D || out_size != M * D || ws_size < WS_END) { fprintf(stderr, "kernel_launch: unexpected problem (n_in %d, ws %zu); nothing launched\n", n_in, ws_size); grid = -1; return; }
        int dev = 0, cus = 0, per_cu = 0;
        if (hipGetDevice(&dev) != hipSuccess || hipDeviceGetAttribute(&cus, hipDeviceAttributeMultiprocessorCount, dev) != hipSuccess) { grid = -1; return; }
        if (hipFuncSetAttribute((const void*)fwd, hipFuncAttributeMaxDynamicSharedMemorySize, LDS_BYTES) != hipSuccess) { grid = -1; return; }
        if (hipOccupancyMaxActiveBlocksPerMultiprocessor(&per_cu, (const void*)fwd, NTHR, LDS_BYTES) != hipSuccess || per_cu < 1) fprintf(stderr, "kernel_launch: occupancy query says %d\n", per_cu);
        (void)hipGetLastError();
        grid = cus;
    }
    if (grid < 0) return;
    (void)hipMemsetAsync((char*)d_ws + WS_CTL, 0, CTL_ZERO_BYTES, stream);
    Args a{};
    for (int i = 0; i < 19; ++i) a.in[i] = (const float*)d_in[i];
    a.out = (float*)d_out; a.ws = (unsigned char*)d_ws; a.pad = 0;
    unsigned char* ws = (unsigned char*)d_ws;
    int li = 0;
    auto run = [&](int plo, int phi) { a.ph_lo = plo; a.ph_hi = phi; a.li = li++; hipLaunchKernelGGL(fwd, dim3(grid), dim3(NTHR), LDS_BYTES, stream, a); };
    run(0, NPH);
}
```
